# Optimizing an MI355X kernel written in HIP

```python
import jax
import jax.numpy as jnp
from jax import lax
import numpy as np

D_MODEL = 1024
BATCH = 8
SEQ = 4096
DEPTH = 2

HEAD_DIM = 64
ROT_DIM = HEAD_DIM // 4
ROPE_THETA = 500000.0
BLOCK_Q = 128
NORM_EPS = 1e-6
D_FF = 2816

DIL_PAIRS = ((128, 1), (512, 4), (2048, 16))
A_GROUPS = len(DIL_PAIRS)
A_SLOTS = 6

B_HEADS = 8
B_KV = 2
B_REP = B_HEADS // B_KV
CMP_BLOCK = 32
CMP_STRIDE = 16
CMP_HIDDEN = 2 * HEAD_DIM
SEL_BLOCK = 64
N_SELECT = 16
WINDOW = 512
FORCE_SCORE = 1e4

C_HEADS = 6

A_WIDTH = A_SLOTS * HEAD_DIM
B_WIDTH = B_HEADS * HEAD_DIM
C_WIDTH = C_HEADS * HEAD_DIM
MIX_WIDTH = A_WIDTH + B_WIDTH + C_WIDTH
A_IN = 3 * A_GROUPS * A_WIDTH
B_Q_IN = B_WIDTH
B_KV_IN = 3 * 2 * B_KV * HEAD_DIM
B_GATE_IN = 3 * B_HEADS
B_IN = B_Q_IN + B_KV_IN + B_GATE_IN
C_IN = 3 * C_WIDTH
IN_WIDTH = A_IN + B_IN + C_IN

kernel_name = 'hybrid_dilated_nsa_stickbreak_macaron'


def rms_norm(x, g):
    xf = x.astype(jnp.float32)
    y = xf * lax.rsqrt(jnp.mean(xf * xf, axis=-1, keepdims=True) + NORM_EPS)
    return (y * g.astype(jnp.float32)).astype(x.dtype)


def swiglu(x, w1, w3, w2):
    return (jax.nn.silu(x @ w1) * (x @ w3)) @ w2


def rope_tables(positions):
    inv = ROPE_THETA ** (-jnp.arange(0, ROT_DIM, 2, dtype=jnp.float32) / ROT_DIM)
    ang = positions.astype(jnp.float32)[..., None] * inv
    return jnp.cos(ang), jnp.sin(ang)


def apply_rope(x, cos, sin):
    half = ROT_DIM // 2
    shp = cos.shape[:2] + (1,) * (x.ndim - 3) + (half,)
    c, s = cos.reshape(shp), sin.reshape(shp)
    xr = x[..., :ROT_DIM].astype(jnp.float32)
    x1, x2 = xr[..., :half], xr[..., half:]
    rot = jnp.concatenate([x1 * c - x2 * s, x2 * c + x1 * s], axis=-1).astype(x.dtype)
    return jnp.concatenate([rot, x[..., ROT_DIM:]], axis=-1)


def masked_softmax(s, mask):
    s = jnp.where(mask, s, -jnp.inf)
    m = jnp.max(s, axis=-1, keepdims=True)
    m = jnp.where(jnp.isfinite(m), m, 0.0)
    p = jnp.exp(s - m)
    l = jnp.sum(p, axis=-1, keepdims=True)
    l_safe = jnp.where(l > 0, l, 1.0)
    return p / l_safe, (m + jnp.log(l_safe))[..., 0]


def band_blocks(x, blk, n_prev):
    n, L = x.shape[:2]
    nb = L // blk
    xb = x.reshape((n, nb, blk) + x.shape[2:])
    xp = jnp.pad(xb, [(0, 0), (n_prev, 0)] + [(0, 0)] * (xb.ndim - 2))
    return jnp.concatenate([xp[:, i:i + nb] for i in range(n_prev + 1)], axis=2)


def banded_attention(q, k, v, blk, n_prev, max_dist):
    n, L, G, R, dh = q.shape
    nb = L // blk
    width = (n_prev + 1) * blk
    qb = q.reshape(n, nb, blk, G, R, dh)
    kb = band_blocks(k, blk, n_prev)
    vb = band_blocks(v, blk, n_prev)
    s = jnp.einsum('nbqgrd,nbkgd->nbgrqk', qb, kb, preferred_element_type=jnp.float32) * (dh ** -0.5)
    qi = jnp.arange(blk)[:, None] + n_prev * blk
    ki = jnp.arange(width)[None, :]
    dist = qi - ki
    key_pos = jnp.arange(nb)[:, None, None] * blk + ki[None] - n_prev * blk
    mask = (dist >= 0) & (dist <= max_dist) & (key_pos >= 0)
    p, lse = masked_softmax(s, mask[:, None, None])
    o = jnp.einsum('nbgrqk,nbkgd->nbqgrd', p, vb.astype(jnp.float32)).astype(q.dtype)
    return o.reshape(n, L, G, R, dh), lse.transpose(0, 1, 4, 2, 3).reshape(n, L, G, R)


def dilated_attention(q, k, v):
    B, S = q.shape[:2]
    outs, lses = [], []
    for g, (window, dil) in enumerate(DIL_PAIRS):
        steps = window // dil
        n_prev = -(-steps // BLOCK_Q)
        unit = dil * BLOCK_Q
        Sp = -(-S // unit) * unit
        M = Sp // dil

        def to_sub(t):
            t = jnp.pad(t, ((0, 0), (0, Sp - S), (0, 0), (0, 0)))
            t = t.reshape(B, M, dil, A_SLOTS, HEAD_DIM).transpose(0, 2, 1, 3, 4)
            return t.reshape(B * dil, M, A_SLOTS, HEAD_DIM)

        qs, ks, vs = to_sub(q[:, :, g]), to_sub(k[:, :, g]), to_sub(v[:, :, g])
        o, lse = banded_attention(qs[:, :, :, None], ks, vs, BLOCK_Q, n_prev, steps)
        o = o[:, :, :, 0].reshape(B, dil, M, A_SLOTS, HEAD_DIM).transpose(0, 2, 1, 3, 4)
        outs.append(o.reshape(B, Sp, A_SLOTS, HEAD_DIM)[:, :S])
        lse = lse[..., 0].reshape(B, dil, M, A_SLOTS).transpose(0, 2, 1, 3)
        lses.append(lse.reshape(B, Sp, A_SLOTS)[:, :S])
    alpha = jax.nn.softmax(jnp.stack(lses, axis=0), axis=0)
    o = jnp.sum(alpha[..., None] * jnp.stack(outs, axis=0).astype(jnp.float32), axis=0)
    return o.reshape(B, S, A_WIDTH).astype(q.dtype)


def nsa_compress(x, pe, w1, w2):
    B, S = x.shape[:2]
    n_chunk = S // CMP_STRIDE
    per = CMP_BLOCK // CMP_STRIDE
    n_cmp = n_chunk - per + 1
    c = x.reshape(B, n_chunk, CMP_STRIDE, B_KV, HEAD_DIM)
    blocks = jnp.concatenate([c[:, i:i + n_cmp] for i in range(per)], axis=2)
    blocks = blocks + pe[:, None, :]
    flat = blocks.transpose(0, 1, 3, 2, 4).reshape(B, n_cmp, B_KV, CMP_BLOCK * HEAD_DIM)
    return jax.nn.gelu(flat @ w1) @ w2


def nsa_attention(q, kv, gate_logits, cos, sin, pe_k, cw1_k, cw2_k, pe_v, cw1_v, cw2_v):
    B, S = q.shape[:2]
    scale = HEAD_DIM ** -0.5
    t = jnp.arange(S)
    per = CMP_BLOCK // CMP_STRIDE
    ratio = SEL_BLOCK // CMP_STRIDE

    kc = nsa_compress(kv[:, :, 0, 0], pe_k, cw1_k, cw2_k)
    vc = nsa_compress(kv[:, :, 0, 1], pe_v, cw1_v, cw2_v)
    n_cmp = kc.shape[1]
    qg = q.reshape(B, S, B_KV, B_REP, HEAD_DIM)
    s = jnp.einsum('bsgrd,bcgd->bgrsc', qg, kc, preferred_element_type=jnp.float32) * scale
    cmp_end = jnp.arange(n_cmp) * CMP_STRIDE + CMP_BLOCK - 1
    p_cmp, _ = masked_softmax(s, cmp_end[None, :] <= t[:, None])
    o_cmp = jnp.einsum('bgrsc,bcgd->bsgrd', p_cmp, vc.astype(jnp.float32))

    n_sel = S // SEL_BLOCK
    imp = jnp.sum(p_cmp, axis=2)
    imp = jnp.pad(imp, ((0, 0), (0, 0), (0, 0), (0, ratio * n_sel + ratio + per - n_cmp)))
    sel_score = imp[..., 0:ratio * n_sel:ratio] * 0.0
    for m in range(ratio):
        for n in range(per):
            sel_score = sel_score + imp[..., m + n:m + n + ratio * n_sel:ratio]
    j = jnp.arange(n_sel)[None, :]
    cur = (t // SEL_BLOCK)[:, None]
    valid = j * SEL_BLOCK <= t[:, None]
    forced = (j == 0) | (j == cur) | (j == cur - 1)
    sel_score = jnp.where(forced, FORCE_SCORE, jnp.where(valid, sel_score, -1.0))
    n_top = min(N_SELECT, n_sel)
    _, idx = lax.top_k(sel_score, n_top)

    qr = apply_rope(q, cos, sin).reshape(B, S, B_KV, B_REP, HEAD_DIM)
    k_slc = apply_rope(kv[:, :, 1, 0], cos, sin)

    def to_sel_blocks(x):
        x = x.reshape(B, n_sel, SEL_BLOCK, B_KV, HEAD_DIM).transpose(0, 3, 1, 2, 4)
        return x.reshape(B, B_KV, n_sel, SEL_BLOCK * HEAD_DIM)

    kb, vb = to_sel_blocks(k_slc), to_sel_blocks(kv[:, :, 1, 1])
    nq = S // BLOCK_Q
    q_steps = qr.reshape(B, nq, BLOCK_Q, B_KV, B_REP, HEAD_DIM).transpose(1, 0, 2, 3, 4, 5)
    idx_steps = idx.reshape(B, B_KV, nq, BLOCK_Q, n_top).transpose(2, 0, 1, 3, 4)
    t_steps = t.reshape(nq, BLOCK_Q)
    bi = jnp.arange(B)[:, None, None]
    gi = jnp.arange(B_KV)[None, :, None]

    def sel_step(args):
        qb, ib, tb = args
        flat = ib.reshape(B, B_KV, BLOCK_Q * n_top)
        kg = kb[bi, gi, flat].reshape(B, B_KV, BLOCK_Q, n_top * SEL_BLOCK, HEAD_DIM)
        vg = vb[bi, gi, flat].reshape(B, B_KV, BLOCK_Q, n_top * SEL_BLOCK, HEAD_DIM)
        kpos = (ib[..., None] * SEL_BLOCK + jnp.arange(SEL_BLOCK)).reshape(B, B_KV, BLOCK_Q, n_top * SEL_BLOCK)
        sc = jnp.einsum('bqgrd,bgqkd->bgrqk', qb, kg, preferred_element_type=jnp.float32) * scale
        p, _ = masked_softmax(sc, (kpos <= tb[:, None])[:, :, None])
        return jnp.einsum('bgrqk,bgqkd->bqgrd', p, vg.astype(jnp.float32))

    o_sel = lax.map(sel_step, (q_steps, idx_steps, t_steps))
    o_sel = o_sel.transpose(1, 0, 2, 3, 4, 5).reshape(B, S, B_KV, B_REP, HEAD_DIM)

    k_win = apply_rope(kv[:, :, 2, 0], cos, sin)
    o_win, _ = banded_attention(qr, k_win, kv[:, :, 2, 1], BLOCK_Q, -(-WINDOW // BLOCK_Q), WINDOW - 1)

    g = jax.nn.sigmoid(gate_logits.astype(jnp.float32)).reshape(B, S, B_KV, B_REP, 3)
    o = g[..., 0:1] * o_cmp + g[..., 1:2] * o_sel + g[..., 2:3] * o_win.astype(jnp.float32)
    return o.reshape(B, S, B_WIDTH).astype(q.dtype)


def stick_breaking_attention(q, k, v):
    B, S, H, dh = q.shape
    nq = S // BLOCK_Q
    scale = dh ** -0.5
    s_pos = jnp.arange(S)
    vf = v.astype(jnp.float32)
    q_steps = q.reshape(B, nq, BLOCK_Q, H, dh).transpose(1, 0, 2, 3, 4)
    t_steps = jnp.arange(S).reshape(nq, BLOCK_Q)

    def step(args):
        qb, tb = args
        z = jnp.einsum('bqhd,bshd->bhqs', qb, k, preferred_element_type=jnp.float32) * scale
        before = s_pos[None, :] < tb[:, None]
        log_1mb = jnp.where(before, jax.nn.log_sigmoid(-z), 0.0)
        between = lax.cumsum(log_1mb, axis=3, reverse=True) - log_1mb
        a = jnp.where(before, jnp.exp(jax.nn.log_sigmoid(z) + between), 0.0)
        return jnp.einsum('bhqs,bshd->bqhd', a, vf)

    o = lax.map(step, (q_steps, t_steps))
    return o.transpose(1, 0, 2, 3, 4).reshape(B, S, H * dh).astype(q.dtype)


def hybrid_layer(x, cos, sin, g_ffn1, f1_w1, f1_w3, f1_w2, g_mix, w_in, pe_k, cw1_k, cw2_k,
                 pe_v, cw1_v, cw2_v, w_gate, w_up, w_out, g_ffn2, f2_w1, f2_w3, f2_w2):
    B, S, D = x.shape
    h = x + 0.5 * swiglu(rms_norm(x, g_ffn1), f1_w1, f1_w3, f1_w2)
    u = rms_norm(h, g_mix)
    proj = u @ w_in
    a_in = proj[..., :A_IN]
    b_in = proj[..., A_IN:A_IN + B_IN]
    c_in = proj[..., A_IN + B_IN:]

    a = a_in.reshape(B, S, 3, A_GROUPS, A_SLOTS, HEAD_DIM)
    qa = apply_rope(a[:, :, 0], cos, sin)
    ka = apply_rope(a[:, :, 1], cos, sin)
    o_a = dilated_attention(qa, ka, a[:, :, 2])

    qb = b_in[..., :B_Q_IN].reshape(B, S, B_HEADS, HEAD_DIM)
    kvb = b_in[..., B_Q_IN:B_Q_IN + B_KV_IN].reshape(B, S, 3, 2, B_KV, HEAD_DIM)
    gb = b_in[..., B_Q_IN + B_KV_IN:]
    o_b = nsa_attention(qb, kvb, gb, cos, sin, pe_k, cw1_k, cw2_k, pe_v, cw1_v, cw2_v)

    c = c_in.reshape(B, S, 3, C_HEADS, HEAD_DIM)
    o_c = stick_breaking_attention(c[:, :, 0], c[:, :, 1], c[:, :, 2])

    gates = jax.nn.sigmoid((u @ w_gate).astype(jnp.float32)).astype(u.dtype).reshape(B, S, 3, D)
    y = (gates[:, :, 0] * (o_a @ w_up[:A_WIDTH])
         + gates[:, :, 1] * (o_b @ w_up[A_WIDTH:A_WIDTH + B_WIDTH])
         + gates[:, :, 2] * (o_c @ w_up[A_WIDTH + B_WIDTH:]))
    h = h + y @ w_out
    return h + 0.5 * swiglu(rms_norm(h, g_ffn2), f2_w1, f2_w3, f2_w2)


def setup_inputs(seed: int = 0) -> dict:
    key = jax.random.key(seed)
    ks = jax.random.split(key, 24)

    def nrm(k, shape, fan_in):
        return jax.random.normal(k, shape, jnp.float32) * (fan_in ** -0.5)

    def gain(k, shape):
        return 1.0 + 0.01 * jax.random.normal(k, shape, jnp.float32)

    L = DEPTH
    x = jax.random.normal(ks[0], (BATCH, SEQ, D_MODEL), jnp.float32)
    offset = jax.random.randint(ks[1], (BATCH, 1), 0, 1024)
    positions = (offset + jnp.arange(SEQ, dtype=jnp.int32)[None, :]).astype(jnp.int32)
    return {
        'x': x,
        'positions': positions,
        'norm_ffn1': gain(ks[2], (L, D_MODEL)),
        'ffn1_w1': nrm(ks[3], (L, D_MODEL, D_FF), D_MODEL),
        'ffn1_w3': nrm(ks[4], (L, D_MODEL, D_FF), D_MODEL),
        'ffn1_w2': nrm(ks[5], (L, D_FF, D_MODEL), D_FF),
        'norm_mix': gain(ks[6], (L, D_MODEL)),
        'w_in': nrm(ks[7], (L, D_MODEL, IN_WIDTH), D_MODEL),
        'cmp_pe_k': 0.1 * jax.random.normal(ks[8], (L, CMP_BLOCK, HEAD_DIM), jnp.float32),
        'cmp_w1_k': nrm(ks[9], (L, CMP_BLOCK * HEAD_DIM, CMP_HIDDEN), CMP_BLOCK * HEAD_DIM),
        'cmp_w2_k': nrm(ks[10], (L, CMP_HIDDEN, HEAD_DIM), CMP_HIDDEN),
        'cmp_pe_v': 0.1 * jax.random.normal(ks[11], (L, CMP_BLOCK, HEAD_DIM), jnp.float32),
        'cmp_w1_v': nrm(ks[12], (L, CMP_BLOCK * HEAD_DIM, CMP_HIDDEN), CMP_BLOCK * HEAD_DIM),
        'cmp_w2_v': nrm(ks[13], (L, CMP_HIDDEN, HEAD_DIM), CMP_HIDDEN),
        'w_gate': nrm(ks[14], (L, D_MODEL, 3 * D_MODEL), D_MODEL),
        'w_up': nrm(ks[15], (L, MIX_WIDTH, D_MODEL), B_WIDTH),
        'w_out': nrm(ks[16], (L, D_MODEL, D_MODEL), D_MODEL),
        'norm_ffn2': gain(ks[17], (L, D_MODEL)),
        'ffn2_w1': nrm(ks[18], (L, D_MODEL, D_FF), D_MODEL),
        'ffn2_w3': nrm(ks[19], (L, D_MODEL, D_FF), D_MODEL),
        'ffn2_w2': nrm(ks[20], (L, D_FF, D_MODEL), D_FF),
        'norm_final': gain(ks[21], (D_MODEL,)),
    }


def reference(x, positions, norm_ffn1, ffn1_w1, ffn1_w3, ffn1_w2, norm_mix, w_in,
              cmp_pe_k, cmp_w1_k, cmp_w2_k, cmp_pe_v, cmp_w1_v, cmp_w2_v,
              w_gate, w_up, w_out, norm_ffn2, ffn2_w1, ffn2_w3, ffn2_w2, norm_final):
    cos, sin = rope_tables(positions)
    h = x
    for i in range(DEPTH):
        h = hybrid_layer(h, cos, sin, norm_ffn1[i], ffn1_w1[i], ffn1_w3[i], ffn1_w2[i],
                         norm_mix[i], w_in[i], cmp_pe_k[i], cmp_w1_k[i], cmp_w2_k[i],
                         cmp_pe_v[i], cmp_w1_v[i], cmp_w2_v[i], w_gate[i], w_up[i], w_out[i],
                         norm_ffn2[i], ffn2_w1[i], ffn2_w3[i], ffn2_w2[i])
    return rms_norm(h, norm_final)
```

```cpp
#include <hip/hip_runtime.h>
#include <hip/hip_cooperative_groups.h>
#include <cstdio>
#include <cstdint>
namespace cg = cooperative_groups;

namespace pg8 {
#define PG8_LAS __attribute__((address_space(3)))
typedef unsigned short bf16_t;
typedef short bf16x8 __attribute__((ext_vector_type(8)));
typedef float f32x4 __attribute__((ext_vector_type(4)));
typedef unsigned u32x4 __attribute__((ext_vector_type(4)));
constexpr int BM = 256, BK = 64, HALF = 128, HTB = HALF * BK * 2  , STAGE_BYTES = 8 * HTB, NXCD = 8, WGM = 8;

__host__ __device__ __forceinline__ int lds_byte(int r, int c) { const int st = (r >> 4) * 2 + (c >> 5), rr = r & 15, cc = c & 31, ob = rr * 64 + cc * 2; return st * 1024 + (ob ^ (((ob >> 9) & 1) << 5)); }
__host__ __device__ __forceinline__ void stage_rc(int b, int& R, int& C) { const int st = b / 1024, sb = b % 1024, swz = sb ^ (((sb >> 9) & 1) << 5); R = (st >> 1) * 16 + swz / 64; C = (st & 1) * 32 + (swz % 64) / 2; }
__host__ __device__ __forceinline__ int perm32(int rho) { const int n = rho >> 4, i = rho & 15; return 8 * (i >> 2) + 4 * n + (i & 3); }

struct Unit { int pm, pn; };
struct Gemm { const bf16_t* A; const bf16_t* Bt; int M, N, K, lda; };

struct StaticOrder {
    int nM, nN, nwg, G, c;
    __host__ __device__ void init(int M, int N, int G_, int c_) { nM = M / BM; nN = N / BM; nwg = nM * nN; G = G_; c = c_; }
    __host__ __device__ bool next(int i, Unit& u) const {
        const long L = (long)i * G + c; if (L >= nwg) return false;
        int wgid = (int)L; { const int q = nwg / NXCD, r = nwg % NXCD, xcd = wgid % NXCD, off = wgid / NXCD; wgid = (xcd < r ? xcd * (q + 1) : r * (q + 1) + (xcd - r) * q) + off; }
        const int nig = WGM * nN, gid = wgid / nig, fm = gid * WGM, gsz = (nM - fm) < WGM ? (nM - fm) : WGM;
        u.pm = fm + ((wgid % nig) % gsz); u.pn = (wgid % nig) / gsz; return true;
    }
    __device__ __forceinline__ void a_ready(const Unit&) const {}
    __device__ __forceinline__ void done(const Unit&) const {}
};

__device__ __forceinline__ unsigned cvt_pk_bf16(float lo, float hi) { unsigned r; asm volatile("v_cvt_pk_bf16_f32 %0, %1, %2" : "=v"(r) : "v"(lo), "v"(hi)); return r; }
typedef float f32x2 __attribute__((ext_vector_type(2)));
template <class Epi, class Sched, bool ALIGN_EPI = false, bool SP2 = false>
__device__ __forceinline__ void gemm_phase(PG8_LAS unsigned char* lds, const Gemm g, const Sched& S, const Epi& E, int wid_in) {
    int lane_l; asm volatile("v_mbcnt_lo_u32_b32 %0, -1, 0\n\tv_mbcnt_hi_u32_b32 %0, -1, %0" : "=v"(lane_l)); int tid_l = wid_in * 64 + lane_l;
    const int tid = tid_l, wid = __builtin_amdgcn_readfirstlane(tid >> 6), lane = tid & 63, wr = wid >> 2, wc = wid & 3, fr = lane & 15, fq = lane >> 4;
    const int K = g.K, nt = K / BK;
    unsigned voffA[2], voffB[2];
#pragma unroll
    for (int i = 0; i < 2; ++i) { int R, C; stage_rc(tid * 16 + i * 8192, R, C); const int Rb = Epi::PERM ? ((R & ~31) + perm32(R & 31)) : R;
        voffA[i] = (unsigned)(R * g.lda + C) * 2u; voffB[i] = (unsigned)(Rb * K + C) * 2u; }
    const size_t kstep = (size_t)(BK * 2);
    const size_t hstepA = (size_t)HALF * g.lda * 2, hstepB = (size_t)HALF * K * 2;
    const size_t tstepA = 2 * hstepA, tstepB = 2 * hstepB;
    const unsigned ldsw = (unsigned)wid * 1024u;
    const int aoff = lds_byte(wr * 64 + fr, fq * 8), boff = lds_byte(wc * 32 + fr, fq * 8);
#define PG8_SA(b, h) (((b) * 2 + (h)) * HTB)
#define PG8_SB(b, h) ((4 + (b) * 2 + (h)) * HTB)
#define PG8_STAGE(bufoff, gbase, voff) do { _Pragma("unroll") for (int _i = 0; _i < 2; ++_i) \
        __builtin_amdgcn_global_load_lds((const unsigned*)((const char*)(gbase) + (voff)[_i]), (PG8_LAS unsigned*)(lds + (bufoff) + ldsw + _i * 8192), 16, 0, 0); } while (0)
#define PG8_LDA(dst, b, h) do { _Pragma("unroll") for (int m = 0; m < 4; ++m) _Pragma("unroll") for (int k = 0; k < 2; ++k) dst[m][k] = *(const PG8_LAS bf16x8*)(lds + PG8_SA(b, h) + aoff + m * 2048 + k * 1024); } while (0)
#define PG8_LDB(dst, b, h) do { _Pragma("unroll") for (int n = 0; n < 2; ++n) _Pragma("unroll") for (int k = 0; k < 2; ++k) dst[n][k] = *(const PG8_LAS bf16x8*)(lds + PG8_SB(b, h) + boff + n * 2048 + k * 1024); } while (0)
#define PG8_MMA(ai, bj, At, Bt) do { __builtin_amdgcn_s_setprio(1); _Pragma("unroll") for (int m = 0; m < 4; ++m) _Pragma("unroll") for (int n = 0; n < 2; ++n) _Pragma("unroll") for (int k = 0; k < 2; ++k) \
        acc[ai][bj][m][n] = __builtin_amdgcn_mfma_f32_16x16x32_bf16(Bt[n][k], At[m][k], acc[ai][bj][m][n], 0, 0, 0); __builtin_amdgcn_s_setprio(0); } while (0)
#define PG8_WAIT_V(n) asm volatile("s_waitcnt vmcnt(" #n ")" ::: "memory")
#define PG8_WAIT_L(n) asm volatile("s_waitcnt lgkmcnt(" #n ")" ::: "memory")
#define PG8_BAR __builtin_amdgcn_s_barrier()
#define PG8_SCHED __builtin_amdgcn_sched_barrier(0)
    Unit cur, nxt; int ui = 0;
    if (!S.next(0, cur)) return;
    f32x4 acc[2][2][4][2];
#pragma unroll
    for (int a = 0; a < 2; ++a)
#pragma unroll
        for (int b = 0; b < 2; ++b)
#pragma unroll
            for (int m = 0; m < 4; ++m)
#pragma unroll
                for (int n = 0; n < 2; ++n) acc[a][b][m][n] = (f32x4){0.f, 0.f, 0.f, 0.f};
    bf16x8 At[4][2], B0[2][2], B1[2][2];
    const char* cA = (const char*)g.A + (size_t)cur.pm * tstepA; const char* cB = (const char*)g.Bt + (size_t)cur.pn * tstepB;
    S.a_ready(cur);
    if constexpr (SP2) {
        PG8_STAGE(PG8_SB(0, 0), cB, voffB); PG8_STAGE(PG8_SB(0, 1), cB + hstepB, voffB); PG8_STAGE(PG8_SA(0, 0), cA, voffA); PG8_STAGE(PG8_SA(0, 1), cA + hstepA, voffA);
        if (wr == 1) PG8_BAR;
        PG8_WAIT_V(2); PG8_BAR;
        PG8_STAGE(PG8_SB(1, 0), cB + kstep, voffB); PG8_STAGE(PG8_SA(1, 0), cA + kstep, voffA); PG8_STAGE(PG8_SB(1, 1), cB + hstepB + kstep, voffB);
        PG8_WAIT_V(6); PG8_BAR;
    } else {
        PG8_STAGE(PG8_SB(0, 0), cB, voffB); PG8_STAGE(PG8_SA(0, 0), cA, voffA); PG8_STAGE(PG8_SB(0, 1), cB + hstepB, voffB); PG8_STAGE(PG8_SA(0, 1), cA + hstepA, voffA);
        if (wr == 1) PG8_BAR;
        PG8_WAIT_V(4); PG8_BAR;
        PG8_STAGE(PG8_SB(1, 0), cB + kstep, voffB); PG8_STAGE(PG8_SA(1, 0), cA + kstep, voffA); PG8_STAGE(PG8_SB(1, 1), cB + hstepB + kstep, voffB);
        PG8_WAIT_V(6); PG8_BAR;
    }
    for (;;) {
        const bool has_next = S.next(ui + 1, nxt);
        const char* nA = has_next ? (const char*)g.A + (size_t)nxt.pm * tstepA : cA; const char* nB = has_next ? (const char*)g.Bt + (size_t)nxt.pn * tstepB : cB;
        for (int t = 0; t < nt; t += 2) {
            const bool last = (t == nt - 2);
            const char* a1 = cA + (size_t)(t + 1) * kstep;
            const char* a2 = last ? nA : cA + (size_t)(t + 2) * kstep; const char* b2 = last ? nB : cB + (size_t)(t + 2) * kstep;
            const char* a3 = a2 + kstep; const char* b3 = b2 + kstep;
            if (last && has_next) S.a_ready(nxt);
            if constexpr (SP2) {
            PG8_LDB(B0, 0, 0); PG8_LDB(B1, 0, 1); PG8_SCHED; PG8_LDA(At, 0, 0); PG8_STAGE(PG8_SA(1, 1), a1 + hstepA, voffA);
            PG8_WAIT_V(8); PG8_WAIT_L(0); PG8_BAR; PG8_MMA(0, 0, At, B0); PG8_MMA(0, 1, At, B1); PG8_BAR; PG8_SCHED;
            PG8_LDA(At, 0, 1); PG8_STAGE(PG8_SB(0, 0), b2, voffB); PG8_STAGE(PG8_SB(0, 1), b2 + hstepB, voffB); PG8_STAGE(PG8_SA(0, 0), a2, voffA);
            PG8_WAIT_V(8); PG8_WAIT_L(0); PG8_BAR; PG8_MMA(1, 0, At, B0); PG8_MMA(1, 1, At, B1); PG8_BAR; PG8_SCHED;
            PG8_LDB(B0, 1, 0); PG8_LDB(B1, 1, 1); PG8_SCHED; PG8_LDA(At, 1, 0); PG8_STAGE(PG8_SA(0, 1), a2 + hstepA, voffA);
            PG8_WAIT_V(8); PG8_WAIT_L(0); PG8_BAR; PG8_MMA(0, 0, At, B0); PG8_MMA(0, 1, At, B1); PG8_BAR; PG8_SCHED;
            PG8_LDA(At, 1, 1); PG8_STAGE(PG8_SB(1, 0), b3, voffB); PG8_STAGE(PG8_SB(1, 1), b3 + hstepB, voffB); PG8_STAGE(PG8_SA(1, 0), a3, voffA);
            PG8_WAIT_V(8); PG8_WAIT_L(0); PG8_BAR; PG8_MMA(1, 0, At, B0); PG8_MMA(1, 1, At, B1); PG8_BAR; PG8_SCHED;
            } else {
            PG8_LDB(B0, 0, 0); PG8_SCHED; PG8_LDA(At, 0, 0); PG8_STAGE(PG8_SA(1, 1), a1 + hstepA, voffA);
            PG8_WAIT_L(8); PG8_BAR; PG8_WAIT_L(0); PG8_MMA(0, 0, At, B0); PG8_BAR; PG8_SCHED;
            PG8_LDB(B1, 0, 1); PG8_STAGE(PG8_SB(0, 0), b2, voffB);
            PG8_BAR; PG8_WAIT_L(0); PG8_MMA(0, 1, At, B1); PG8_BAR;
            PG8_LDA(At, 0, 1); PG8_STAGE(PG8_SA(0, 0), a2, voffA);
            PG8_BAR; PG8_WAIT_L(0); PG8_MMA(1, 0, At, B0); PG8_BAR; PG8_SCHED;
            PG8_STAGE(PG8_SB(0, 1), b2 + hstepB, voffB);
            PG8_WAIT_V(6); PG8_BAR; PG8_MMA(1, 1, At, B1); PG8_BAR;
            PG8_LDB(B0, 1, 0); PG8_SCHED; PG8_LDA(At, 1, 0); PG8_STAGE(PG8_SA(0, 1), a2 + hstepA, voffA);
            PG8_WAIT_L(8); PG8_BAR; PG8_WAIT_L(0); PG8_MMA(0, 0, At, B0); PG8_BAR; PG8_SCHED;
            PG8_LDB(B1, 1, 1); PG8_STAGE(PG8_SB(1, 0), b3, voffB);
            PG8_BAR; PG8_WAIT_L(0); PG8_MMA(0, 1, At, B1); PG8_BAR;
            PG8_LDA(At, 1, 1); PG8_STAGE(PG8_SA(1, 0), a3, voffA);
            PG8_BAR; PG8_WAIT_L(0); PG8_MMA(1, 0, At, B0); PG8_BAR; PG8_SCHED;
            PG8_STAGE(PG8_SB(1, 1), b3 + hstepB, voffB);
            PG8_WAIT_V(6); PG8_BAR; PG8_MMA(1, 1, At, B1); PG8_BAR;
            }
        }
        if constexpr (ALIGN_EPI) { if (wr == 0) PG8_BAR; }
        if constexpr (!Epi::AFTER_DRAIN) { E(acc, cur, wr, wc, fr, fq); S.done(cur); }
        if (!has_next) break;
#pragma unroll
        for (int a = 0; a < 2; ++a)
#pragma unroll
            for (int b = 0; b < 2; ++b)
#pragma unroll
                for (int m = 0; m < 4; ++m)
#pragma unroll
                    for (int n = 0; n < 2; ++n) acc[a][b][m][n] = (f32x4){0.f, 0.f, 0.f, 0.f};
        cur = nxt; cA = nA; cB = nB; ++ui;
        if constexpr (ALIGN_EPI) { if (wr == 1) PG8_BAR; }
    }
    PG8_WAIT_V(0);
    if constexpr (!ALIGN_EPI) { if (wr == 0) PG8_BAR; }
    PG8_BAR;
    if constexpr (Epi::AFTER_DRAIN) { E.fused(acc, cur, wr, wc, fr, fq, lds, wid, lane); S.done(cur); }
#undef PG8_SA
#undef PG8_SB
#undef PG8_STAGE
#undef PG8_LDA
#undef PG8_LDB
#undef PG8_MMA
#undef PG8_WAIT_V
#undef PG8_WAIT_L
#undef PG8_BAR
#undef PG8_SCHED
}
}


typedef unsigned short bf16_t;
typedef short bf16x8 __attribute__((ext_vector_type(8)));
typedef float f32x4 __attribute__((ext_vector_type(4)));
typedef unsigned u32x4 __attribute__((ext_vector_type(4)));
typedef unsigned u32x2 __attribute__((ext_vector_type(2)));
#define LAS __attribute__((address_space(3)))

constexpr int NB = 8, S = 4096, T = NB * S, D = 1024, FF = 2816, DEPTH = 2;
constexpr int HBAT = 4, TH = HBAT * S;
constexpr int NIN = 9216, NPROJ = 6144;
constexpr size_t MiB = 1u << 20;
constexpr size_t E = (size_t)S * 64;
constexpr int NTHREADS = 512, NWAVES = 8;
constexpr int LDS_BYTES = 132 * 1024;
constexpr int LDS_MISC = 131072;

constexpr size_t WS_CTL = 0;
constexpr size_t WS_CS = 1 * MiB;
constexpr size_t WS_W13 = 3 * MiB;
constexpr size_t WS_W2 = 14 * MiB;
constexpr size_t WS_WIN = 20 * MiB;
constexpr size_t WS_WUP = 39 * MiB;
constexpr size_t WS_WOUT = 42 * MiB;
constexpr size_t WS_CW1 = 44 * MiB;
constexpr size_t WS_CW2 = 45 * MiB;
constexpr size_t WS_KC = 46 * MiB;
constexpr size_t WS_U = 48 * MiB;
constexpr size_t WS_R = 112 * MiB;
constexpr size_t MB_QA = 0, MB_KA = 36 * MiB, MB_VA = 72 * MiB;
constexpr size_t MB_QB = 108 * MiB, MB_QBR = 124 * MiB;
constexpr size_t MB_KV = 140 * MiB;
constexpr size_t MB_GB = 164 * MiB;
constexpr size_t MB_QC = 166 * MiB, MB_KC = 178 * MiB, MB_VC = 190 * MiB;
constexpr size_t MB_G = 202 * MiB;
constexpr size_t MB_O = 298 * MiB;
constexpr size_t MB_Y = MB_QA;
constexpr size_t MB_VRM = 338 * MiB;
constexpr size_t WS_NEED = WS_R + 394 * MiB;

__constant__ float ROPE_INV[8] = {1.0f, 0.1939227432012558f, 0.03760603070259094f, 0.007292664609849453f,
                                  0.0014142135623842478f, 0.00027424818836152554f, 5.318296098266728e-05f, 1.0313386155758053e-05f};

typedef float f32x2_t __attribute__((ext_vector_type(2)));
typedef __bf16 bf16x2_t __attribute__((ext_vector_type(2)));
__device__ __forceinline__ unsigned pk_bf16(float lo, float hi) { f32x2_t v = {lo, hi}; bf16x2_t b = __builtin_convertvector(v, bf16x2_t); return __builtin_bit_cast(unsigned, b); }
__device__ __forceinline__ float bflo(unsigned w) { return __builtin_bit_cast(float, w << 16); }
__device__ __forceinline__ float bfhi(unsigned w) { return __builtin_bit_cast(float, w & 0xffff0000u); }
__device__ __forceinline__ float fexp2(float x) { return __builtin_amdgcn_exp2f(x); }
__device__ __forceinline__ float flog2(float x) { return __builtin_amdgcn_logf(x); }
__device__ __forceinline__ float frcp(float x) { return __builtin_amdgcn_rcpf(x); }
__device__ __forceinline__ bf16x8 pack8(f32x4 a, f32x4 b) {
    u32x4 w; w.x = pk_bf16(a[0], a[1]); w.y = pk_bf16(a[2], a[3]); w.z = pk_bf16(b[0], b[1]); w.w = pk_bf16(b[2], b[3]);
    return __builtin_bit_cast(bf16x8, w);
}
__device__ __forceinline__ bf16x8 ld16(const bf16_t* p) { return *(const bf16x8*)p; }
__device__ __forceinline__ f32x4 mfma16(bf16x8 a, bf16x8 b, f32x4 c) { return __builtin_amdgcn_mfma_f32_16x16x32_bf16(a, b, c, 0, 0, 0); }
__device__ __forceinline__ int perm32pos(int p) { return (p & ~31) | ((((p & 15) >> 2) << 3) + (((p >> 4) & 1) << 2) + (p & 3)); }
__device__ __forceinline__ float shx(float v, int mask, int lane) { return __builtin_bit_cast(float, __builtin_amdgcn_ds_bpermute((lane ^ mask) << 2, __builtin_bit_cast(int, v))); }
__device__ __forceinline__ float shi(float v, int src) { return __builtin_bit_cast(float, __builtin_amdgcn_ds_bpermute(src << 2, __builtin_bit_cast(int, v))); }
__device__ __forceinline__ float qx1(float v) { return __builtin_bit_cast(float, __builtin_amdgcn_update_dpp(0, __builtin_bit_cast(int, v), 0xB1, 0xF, 0xF, true)); }
__device__ __forceinline__ float qx2(float v) { return __builtin_bit_cast(float, __builtin_amdgcn_update_dpp(0, __builtin_bit_cast(int, v), 0x4E, 0xF, 0xF, true)); }
constexpr float LOG2E = 1.4426950408889634f, LN2 = 0.6931471805599453f;

struct EpiFfnUp {
    static constexpr bool PERM = true, AFTER_DRAIN = false;
    bf16_t* O;
    __device__ __forceinline__ void operator()(const f32x4 (&acc)[2][2][4][2], const pg8::Unit& u, int wr, int wc, int fr_in, int fq_in) const {
        int lane_e; asm volatile("v_mbcnt_lo_u32_b32 %0, -1, 0\n\tv_mbcnt_hi_u32_b32 %0, -1, %0" : "=v"(lane_e)); const int fr = lane_e & 15, fq = lane_e >> 4; (void)fr_in; (void)fq_in;
        const int row0 = u.pm * 256 + wr * 64 + fr, col0 = u.pn * 128 + wc * 32 + 8 * fq;
        bf16_t* rowp = O + (size_t)row0 * FF + col0;
#pragma unroll
        for (int ai = 0; ai < 2; ++ai) {
#pragma unroll
            for (int m = 0; m < 4; ++m) {
                float r[8];
#pragma unroll
                for (int e = 0; e < 8; ++e) { const float a = acc[ai][0][m][e >> 2][e & 3], b = acc[ai][1][m][e >> 2][e & 3]; r[e] = a * frcp(1.f + fexp2(-a * LOG2E)) * b; }
                u32x4 w; w.x = pk_bf16(r[0], r[1]); w.y = pk_bf16(r[2], r[3]); w.z = pk_bf16(r[4], r[5]); w.w = pk_bf16(r[6], r[7]);
                *(u32x4*)rowp = w;
                rowp += (size_t)16 * FF; asm volatile("" : "+v"(rowp)); }
            rowp += (size_t)64 * FF; asm volatile("" : "+v"(rowp)); }
    }
};
struct EpiResid {
    static constexpr bool PERM = true, AFTER_DRAIN = false;
    const float* src; float* dst; float scale;
    __device__ __forceinline__ void operator()(const f32x4 (&acc)[2][2][4][2], const pg8::Unit& u, int wr, int wc, int fr_in, int fq_in) const {
        int lane_e; asm volatile("v_mbcnt_lo_u32_b32 %0, -1, 0\n\tv_mbcnt_hi_u32_b32 %0, -1, %0" : "=v"(lane_e)); const int fr = lane_e & 15, fq = lane_e >> 4; (void)fr_in; (void)fq_in;
        const int row0 = u.pm * 256 + wr * 64 + fr, col0 = u.pn * 256 + wc * 32 + 8 * fq;
        const float* sp = src + (size_t)row0 * D + col0; float* dp = dst + (size_t)row0 * D + col0;
#pragma unroll
        for (int ai = 0; ai < 2; ++ai) {
            f32x4 sv[4][2][2];
#pragma unroll
            for (int m = 0; m < 4; ++m)
#pragma unroll
                for (int bj = 0; bj < 2; ++bj) { sv[m][bj][0] = *(const f32x4*)(sp + m * 16 * D + bj * 128); sv[m][bj][1] = *(const f32x4*)(sp + m * 16 * D + bj * 128 + 4); }
#pragma unroll
            for (int m = 0; m < 4; ++m)
#pragma unroll
                for (int bj = 0; bj < 2; ++bj) { *(f32x4*)(dp + m * 16 * D + bj * 128) = sv[m][bj][0] + acc[ai][bj][m][0] * scale; *(f32x4*)(dp + m * 16 * D + bj * 128 + 4) = sv[m][bj][1] + acc[ai][bj][m][1] * scale; }
            sp += 128 * D; dp += 128 * D; asm volatile("" : "+v"(sp), "+v"(dp)); }
    }
};
template <bool FIRST> struct EpiUpMerge {
    static constexpr bool PERM = true, AFTER_DRAIN = false;
    const bf16_t* G; bf16_t* Y;
    __device__ __forceinline__ void operator()(const f32x4 (&acc)[2][2][4][2], const pg8::Unit& u, int wr, int wc, int fr_in, int fq_in) const {
        int lane_e; asm volatile("v_mbcnt_lo_u32_b32 %0, -1, 0\n\tv_mbcnt_hi_u32_b32 %0, -1, %0" : "=v"(lane_e)); const int fr = lane_e & 15, fq = lane_e >> 4; (void)fr_in; (void)fq_in;
        const int row0 = u.pm * 256 + wr * 64 + fr, col0 = u.pn * 256 + wc * 32 + 8 * fq;
        const bf16_t* gp = G + (size_t)row0 * 3072 + col0; bf16_t* yp = Y + (size_t)row0 * D + col0;
#pragma unroll
        for (int ai = 0; ai < 2; ++ai) {
            u32x4 gv[4][2], yv[4][2];
#pragma unroll
            for (int m = 0; m < 4; ++m)
#pragma unroll
                for (int bj = 0; bj < 2; ++bj) { gv[m][bj] = *(const u32x4*)(gp + m * 16 * 3072 + bj * 128); if (!FIRST) yv[m][bj] = *(const u32x4*)(yp + m * 16 * D + bj * 128); }
#pragma unroll
            for (int m = 0; m < 4; ++m)
#pragma unroll
                for (int bj = 0; bj < 2; ++bj) {
                    const f32x4 a0 = acc[ai][bj][m][0], a1 = acc[ai][bj][m][1];
                    f32x4 y0 = {0.f, 0.f, 0.f, 0.f}, y1 = {0.f, 0.f, 0.f, 0.f};
                    if (!FIRST) { const u32x4 t = yv[m][bj]; y0 = (f32x4){bflo(t.x), bfhi(t.x), bflo(t.y), bfhi(t.y)}; y1 = (f32x4){bflo(t.z), bfhi(t.z), bflo(t.w), bfhi(t.w)}; }
                    const u32x4 g4 = gv[m][bj];
                    y0 += (f32x4){bflo(g4.x), bfhi(g4.x), bflo(g4.y), bfhi(g4.y)} * a0;
                    y1 += (f32x4){bflo(g4.z), bfhi(g4.z), bflo(g4.w), bfhi(g4.w)} * a1;
                    u32x4 w; w.x = pk_bf16(y0[0], y0[1]); w.y = pk_bf16(y0[2], y0[3]); w.z = pk_bf16(y1[0], y1[1]); w.w = pk_bf16(y1[2], y1[3]);
                    *(u32x4*)(yp + m * 16 * D + bj * 128) = w; }
            gp += 128 * 3072; yp += 128 * D; asm volatile("" : "+v"(gp), "+v"(yp)); }
    }
};
struct EpiInProj {
    static constexpr bool PERM = true, AFTER_DRAIN = false;
    unsigned char* mb; const float* cs;
    __device__ __forceinline__ void operator()(const f32x4 (&acc)[2][2][4][2], const pg8::Unit& u, int wr, int wc, int fr_in, int fq_in) const {
        int lane_e; asm volatile("v_mbcnt_lo_u32_b32 %0, -1, 0\n\tv_mbcnt_hi_u32_b32 %0, -1, %0" : "=v"(lane_e)); const int fr = lane_e & 15, fq = lane_e >> 4; (void)fr_in; (void)fq_in;
        const int row0 = u.pm * 256 + wr * 64 + fr;
#pragma unroll
        for (int bj = 0; bj < 2; ++bj) {
            const int cb = u.pn * 256 + bj * 128 + wc * 32;
            const int hc = cb >> 6;
            if (hc >= 93 && hc < 96) continue;
            const int dd = (cb & 63) + 8 * fq;
            if (hc >= 96) {
                bf16_t* G = (bf16_t*)(mb + MB_G);
#pragma unroll
                for (int ai = 0; ai < 2; ++ai)
#pragma unroll
                    for (int m = 0; m < 4; ++m) { const size_t row = (size_t)(row0 + ai * 128 + m * 16); float v[8];
#pragma unroll
                        for (int e = 0; e < 8; ++e) { const float x = acc[ai][bj][m][e >> 2][e & 3]; v[e] = frcp(1.f + fexp2(-x * LOG2E)); }
                        u32x4 w; w.x = pk_bf16(v[0], v[1]); w.y = pk_bf16(v[2], v[3]); w.z = pk_bf16(v[4], v[5]); w.w = pk_bf16(v[6], v[7]);
                        *(u32x4*)(G + row * 3072 + (cb - NPROJ) + 8 * fq) = w; }
                continue;
            }
            if (hc == 74) {
                float* GBp = (float*)(mb + MB_GB);
                if (dd < 24) {
#pragma unroll
                    for (int ai = 0; ai < 2; ++ai)
#pragma unroll
                        for (int m = 0; m < 4; ++m) { const size_t row = (size_t)(row0 + ai * 128 + m * 16);
#pragma unroll
                            for (int e = 0; e < 8; ++e) { const float x = acc[ai][bj][m][e >> 2][e & 3]; GBp[row * 24 + dd + e] = frcp(1.f + fexp2(-x * LOG2E)); } }
                }
                continue;
            }
            size_t boff; int nh, hd, dl = 0; bool rope = false, tr = false;
            if (hc < 54) { const int g = hc / 18, kd = (hc % 18) / 6; hd = hc % 6; nh = 6; boff = (kd == 0 ? MB_QA : (kd == 1 ? MB_KA : MB_VRM)) + (size_t)g * 12 * MiB; rope = kd < 2; }
            else if (hc < 62) { boff = MB_QB; nh = 8; hd = hc - 54; }
            else if (hc < 74) { const int idx = hc - 62, br = idx >> 2, kvt = (idx >> 1) & 1; hd = idx & 1; nh = 2; boff = (kvt == 1 && br >= 1) ? MB_VRM + (size_t)(32 + 4 * br) * MiB : MB_KV + (size_t)(br * 2 + kvt) * 4 * MiB; rope = (kvt == 0 && br >= 1); }
            else { const int idx = hc - 75, kd = idx / 6; hd = idx % 6; nh = 6; boff = kd == 0 ? MB_QC : (kd == 1 ? MB_KC : MB_VRM + 44 * MiB); }
            bf16_t* base = (bf16_t*)(mb + boff);
            const bool dorope = rope && ((cb & 63) == 0);
#pragma unroll
            for (int ai = 0; ai < 2; ++ai) {
                f32x4 cv[4][4];
                if (dorope) {
#pragma unroll
                    for (int m = 0; m < 4; ++m) { const f32x4* c = (const f32x4*)(cs + (size_t)(row0 + ai * 128 + m * 16) * 16); cv[m][0] = c[0]; cv[m][1] = c[1]; cv[m][2] = c[2]; cv[m][3] = c[3]; }
                }
#pragma unroll
                for (int m = 0; m < 4; ++m) {
                    const int row = row0 + ai * 128 + m * 16; const int hb = row >> 12, t = row & (S - 1);
                    float v[8];
#pragma unroll
                    for (int e = 0; e < 8; ++e) v[e] = acc[ai][bj][m][e >> 2][e & 3];
                    if (dorope) {
#pragma unroll
                        for (int e = 0; e < 8; ++e) { const float other = shx(v[e], 16, fr + 16 * fq);
                            if (fq < 2) { const float co = cv[m][e >> 2][e & 3], si = cv[m][2 + (e >> 2)][e & 3]; v[e] = (fq == 0) ? (v[e] * co - other * si) : (v[e] * co + other * si); } }
                    }
                    u32x4 w; w.x = pk_bf16(v[0], v[1]); w.y = pk_bf16(v[2], v[3]); w.z = pk_bf16(v[4], v[5]); w.w = pk_bf16(v[6], v[7]);
                    *(u32x4*)(base + ((size_t)(hb * nh + hd) * S + t) * 64 + dd) = w;
                }
            }
        }
    }
};
__device__ __forceinline__ int in_orig_col(int n) {
    const int hc = n >> 6, d = n & 63;
    if (hc < 54) { const int g = hc / 18, kd = (hc % 18) / 6, slot = hc % 6; return ((kd * 3 + g) * 6 + slot) * 64 + d; }
    if (hc < 62) return 3456 + (hc - 54) * 64 + d;
    if (hc < 74) return 3968 + (hc - 62) * 64 + d;
    if (hc == 74) return d < 24 ? 4736 + d : -1;
    if (hc < 93) return 4760 + (hc - 75) * 64 + d;
    return -1;
}

template <class Epi> __device__ __forceinline__ void run_gemm(LAS unsigned char* lds, const bf16_t* A, int lda, const bf16_t* Bt, int M, int N, int K, const Epi& Ep, int wid_in) {
    int bid = blockIdx.x; asm volatile("" : "+s"(A), "+s"(Bt), "+s"(bid));
    pg8::Gemm g{A, Bt, M, N, K, lda}; pg8::StaticOrder So; So.init(M, N, (int)gridDim.x, bid);
    pg8::gemm_phase<Epi, pg8::StaticOrder, true, true>(lds, g, So, Ep, wid_in);
}

struct AState { f32x4 o[4]; float m, l; };
__device__ __forceinline__ void st_init(AState& a) {
#pragma unroll
    for (int i = 0; i < 4; ++i) a.o[i] = (f32x4){0.f, 0.f, 0.f, 0.f};
    a.m = -1e30f; a.l = 0.f;
}
struct KV { bf16x8 k[4][2]; bf16x8 v[4][2]; };
__device__ __forceinline__ void load_kv(KV& t, const bf16_t* k0, size_t kstride, const bf16_t* vb, size_t vpitch, int g) {
#pragma unroll
    for (int kt = 0; kt < 4; ++kt) { const bf16_t* kr = k0 + kt * kstride; t.k[kt][0] = ld16(kr + 8 * g); t.k[kt][1] = ld16(kr + 32 + 8 * g); }
#pragma unroll
    for (int dt = 0; dt < 4; ++dt)
#pragma unroll
        for (int c = 0; c < 2; ++c) t.v[dt][c] = ld16(vb + (size_t)(16 * dt) * vpitch + c * 32);
}
__device__ __forceinline__ void qk_compute(f32x4 (&s)[4], const KV& t, const bf16x8 (&qf)[2]) {
#pragma unroll
    for (int kt = 0; kt < 4; ++kt) { s[kt] = mfma16(t.k[kt][0], qf[0], (f32x4){0.f, 0.f, 0.f, 0.f}); s[kt] = mfma16(t.k[kt][1], qf[1], s[kt]); }
}
__device__ __forceinline__ void softmax_pv(AState& a, f32x4 (&s)[4], unsigned vm, const bf16x8 (&vf)[4][2], int lane) {
    const float C2 = 0.125f * LOG2E;
    float mx = -1e30f;
#pragma unroll
    for (int kt = 0; kt < 4; ++kt)
#pragma unroll
        for (int j = 0; j < 4; ++j) { const float v = ((vm >> (kt * 4 + j)) & 1u) ? s[kt][j] * C2 : -__builtin_inff(); s[kt][j] = v; mx = fmaxf(mx, v); }
    mx = fmaxf(mx, shx(mx, 16, lane)); mx = fmaxf(mx, shx(mx, 32, lane));
    const float mn = fmaxf(a.m, mx);
    const float alpha = fexp2(a.m - mn);
    a.m = mn;
    float ps = 0.f;
#pragma unroll
    for (int kt = 0; kt < 4; ++kt)
#pragma unroll
        for (int j = 0; j < 4; ++j) { const float p = fexp2(s[kt][j] - mn); s[kt][j] = p; ps += p; }
    a.l = a.l * alpha + ps;
    const bf16x8 p0 = pack8(s[0], s[1]), p1 = pack8(s[2], s[3]);
#pragma unroll
    for (int dt = 0; dt < 4; ++dt) { a.o[dt] = a.o[dt] * alpha; a.o[dt] = mfma16(vf[dt][0], p0, a.o[dt]); a.o[dt] = mfma16(vf[dt][1], p1, a.o[dt]); }
}
__device__ __forceinline__ void softmax_pv_nomask(AState& a, f32x4 (&s)[4], float bias, const bf16x8 (&vf)[4][2], int lane) {
    const float C2 = 0.125f * LOG2E;
    float mx = -1e30f;
#pragma unroll
    for (int kt = 0; kt < 4; ++kt)
#pragma unroll
        for (int j = 0; j < 4; ++j) { const float v = fmaf(s[kt][j], C2, bias); s[kt][j] = v; mx = fmaxf(mx, v); }
    mx = fmaxf(mx, shx(mx, 16, lane)); mx = fmaxf(mx, shx(mx, 32, lane));
    const float mn = fmaxf(a.m, mx);
    const float alpha = fexp2(a.m - mn);
    a.m = mn;
    float ps = 0.f;
#pragma unroll
    for (int kt = 0; kt < 4; ++kt)
#pragma unroll
        for (int j = 0; j < 4; ++j) { const float p = fexp2(s[kt][j] - mn); s[kt][j] = p; ps += p; }
    a.l = a.l * alpha + ps;
    const bf16x8 p0 = pack8(s[0], s[1]), p1 = pack8(s[2], s[3]);
#pragma unroll
    for (int dt = 0; dt < 4; ++dt) { a.o[dt] = a.o[dt] * alpha; a.o[dt] = mfma16(vf[dt][0], p0, a.o[dt]); a.o[dt] = mfma16(vf[dt][1], p1, a.o[dt]); }
}
__device__ __forceinline__ float st_inv_l(const AState& a, int lane) {
    float l = a.l; l += shx(l, 16, lane); l += shx(l, 32, lane);
    return l > 0.f ? 1.f / l : 0.f;
}
__device__ __forceinline__ void store_o(bf16_t* dst  , const f32x4 (&o)[4], int g) {
#pragma unroll
    for (int dt = 0; dt < 4; ++dt) { u32x2 w; w.x = pk_bf16(o[dt][0], o[dt][1]); w.y = pk_bf16(o[dt][2], o[dt][3]); *(u32x2*)(dst + 16 * dt + 4 * g) = w; }
}

struct Stg { bf16x8 k, v; };
__device__ __forceinline__ void stg_load(Stg& r, const bf16_t* K, const bf16_t* Vt, int kb, int tid) {
    const int row = tid >> 3, ch = tid & 7;
    r.k = ld16(K + (size_t)(64 * kb + row) * 64 + 8 * ch); r.v = ld16(Vt + (size_t)row * S + 64 * kb + 8 * ch);
}
__device__ __forceinline__ void stg_store(const Stg& r, LAS bf16_t* buf, int tid) {
    const int off = (tid >> 3) * 72 + 8 * (tid & 7);
    *(LAS bf16x8*)(buf + off) = r.k; *(LAS bf16x8*)(buf + 4608 + off) = r.v;
}
__device__ __forceinline__ void lds_frags(KV& t, const LAS bf16_t* buf, int li, int g) {
#pragma unroll
    for (int kt = 0; kt < 4; ++kt) { t.k[kt][0] = *(const LAS bf16x8*)(buf + (16 * kt + li) * 72 + 8 * g); t.k[kt][1] = *(const LAS bf16x8*)(buf + (16 * kt + li) * 72 + 32 + 8 * g); }
#pragma unroll
    for (int dt = 0; dt < 4; ++dt)
#pragma unroll
        for (int c = 0; c < 2; ++c) t.v[dt][c] = *(const LAS bf16x8*)(buf + 4608 + (16 * dt + li) * 72 + c * 32 + 8 * g);
}

__device__ __forceinline__ void attn_A_wave(const unsigned char* mb, int hb, int slot, int tblk, int r, int lane, int w, LAS unsigned char* ldsb) {
    const int g = lane >> 4, li = lane & 15;
    const int tq = 256 * tblk + r + 16 * li;
    AState st; st_init(st);
#pragma unroll
    for (int gi = 0; gi < 3; ++gi) {
        const int dl = 2 * gi, L = S >> dl;
        const int rho = r & ((1 << dl) - 1);
        const int mq = tq >> dl;
        const size_t hoff = (size_t)(hb * 6 + slot) * E;
        const bf16_t* Q = (const bf16_t*)(mb + MB_QA + (size_t)gi * 12 * MiB) + hoff;
        const bf16_t* K = (const bf16_t*)(mb + MB_KA + (size_t)gi * 12 * MiB) + hoff;
        const bf16_t* Vt = (const bf16_t*)(mb + MB_VA + (size_t)gi * 12 * MiB) + hoff;
        bf16x8 qf[2]; qf[0] = ld16(Q + (size_t)tq * 64 + 8 * g); qf[1] = ld16(Q + (size_t)tq * 64 + 32 + 8 * g);
        const int mq_min = (256 * tblk + r) >> dl, mq_max = (256 * tblk + r + 240) >> dl;
        const int tlo = (mq_min > 128 ? mq_min - 128 : 0) >> 6, thi = mq_max >> 6;
        if (gi == 0) {
            const int tid = w * 64 + lane;
            LAS bf16_t* tb0 = (LAS bf16_t*)(ldsb + 16384); LAS bf16_t* tb1 = tb0 + 9216;
            const int tlo0 = 4 * tblk - 2 > 0 ? 4 * tblk - 2 : 0, thi0 = 4 * tblk + 3;
            int cur = 0;
            { Stg r_; stg_load(r_, K, Vt, tlo0, tid); stg_store(r_, tb0, tid); }
            __syncthreads();
            for (int kb = tlo0; kb <= thi0; ++kb) {
                const bool hn = kb < thi0; Stg rn;
                if (hn) stg_load(rn, K, Vt, kb + 1, tid);
                { KV t; lds_frags(t, cur ? tb1 : tb0, li, g);
                  f32x4 s[4]; qk_compute(s, t, qf); unsigned vm = 0;
#pragma unroll
                  for (int kt = 0; kt < 4; ++kt)
#pragma unroll
                      for (int j = 0; j < 4; ++j) { const int dist = mq - (64 * kb + 16 * kt + 4 * g + j); if (dist >= 0 && dist <= 128) vm |= 1u << (kt * 4 + j); }
                  softmax_pv(st, s, vm, t.v, lane); }
                if (hn) stg_store(rn, cur ? tb0 : tb1, tid);
                __syncthreads();
                cur ^= 1;
            }
        } else {
        const bf16_t* kbase = K + (size_t)(rho + (li << dl)) * 64; const size_t ktile = (size_t)64 << (6 + dl), ksub = (size_t)16 << (6 + dl);
        const bf16_t* vbase = Vt + (size_t)li * S + rho * L + 8 * g;
#define A_LOAD(T, tl) load_kv(T, kbase + (size_t)(tl) * ktile, ksub, vbase + 64 * (tl), S, g)
#define A_STEP(T, tl) do { f32x4 s[4]; qk_compute(s, T, qf); unsigned vm = 0; _Pragma("unroll") for (int kt = 0; kt < 4; ++kt) _Pragma("unroll") for (int j = 0; j < 4; ++j) { \
            const int dist = mq - (64 * (tl) + 16 * kt + 4 * g + j); if (dist >= 0 && dist <= 128) vm |= 1u << (kt * 4 + j); } softmax_pv(st, s, vm, T.v, lane); } while (0)
        KV ta, tb;
        A_LOAD(ta, tlo);
        for (int tile = tlo; tile <= thi; tile += 2) {
            A_LOAD(tb, tile + 1 <= thi ? tile + 1 : thi);
            A_STEP(ta, tile);
            if (tile + 1 > thi) break;
            A_LOAD(ta, tile + 2 <= thi ? tile + 2 : thi);
            A_STEP(tb, tile + 1);
        }
#undef A_LOAD
#undef A_STEP
        }
    }
    const float inv = st_inv_l(st, lane);
#pragma unroll
    for (int dt = 0; dt < 4; ++dt) st.o[dt] = st.o[dt] * inv;
    store_o((bf16_t*)(mb + MB_O) + ((size_t)hb * S + tq) * 1280 + slot * 64, st.o, g);
}

__device__ __forceinline__ void attn_C_wave(const unsigned char* mb, int hb, int head, int qb, int w, int lane) {
    const int g = lane >> 4, li = lane & 15;
    const int tq = 128 * qb + 16 * w + li;
    const size_t hoff = (size_t)(hb * 6 + head) * E;
    const bf16_t* Q = (const bf16_t*)(mb + MB_QC) + hoff;
    const bf16_t* K = (const bf16_t*)(mb + MB_KC) + hoff;
    const bf16_t* Vt = (const bf16_t*)(mb + MB_VC) + hoff;
    bf16x8 qf[2]; qf[0] = ld16(Q + (size_t)tq * 64 + 8 * g); qf[1] = ld16(Q + (size_t)tq * 64 + 32 + 8 * g);
    f32x4 o[4];
#pragma unroll
    for (int i = 0; i < 4; ++i) o[i] = (f32x4){0.f, 0.f, 0.f, 0.f};
    float R = 0.f;
    const int thi = (128 * qb + 16 * w + 14) >> 6;
    const bf16_t* kbase = K + (size_t)li * 64; const bf16_t* vbase = Vt + (size_t)li * S + 8 * g;
#define C_LOAD(T, tl) load_kv(T, kbase + (size_t)(tl) * 4096, 1024, vbase + 64 * (tl), S, g)
#define C_STEP(T, tl) do { f32x4 s[4]; qk_compute(s, T, qf); f32x4 Lm[4], Lp[4]; float tot[4], sgt[4]; \
        _Pragma("unroll") for (int kt = 0; kt < 4; ++kt) { float gs = 0.f; \
            _Pragma("unroll") for (int j = 0; j < 4; ++j) { const int key = 64 * (tl) + 16 * kt + 4 * g + j; const bool valid = key < tq; \
                const float z = s[kt][j] * 0.125f; const float e = fexp2(-fabsf(z) * LOG2E); const float sp = fmaxf(z, 0.f) + flog2(1.f + e) * LN2; \
                Lm[kt][j] = valid ? -sp : 0.f; Lp[kt][j] = valid ? (z - sp) : -1e30f; gs += Lm[kt][j]; } \
            const float x1 = shx(gs, 16, lane), x2 = shx(gs, 32, lane), x3 = shx(gs, 48, lane); \
            tot[kt] = gs + x1 + x2 + x3; \
            sgt[kt] = (((g ^ 1) > g) ? x1 : 0.f) + (((g ^ 2) > g) ? x2 : 0.f) + (((g ^ 3) > g) ? x3 : 0.f); } \
        float off[4]; off[3] = R + sgt[3]; off[2] = R + tot[3] + sgt[2]; off[1] = R + tot[3] + tot[2] + sgt[1]; off[0] = R + tot[3] + tot[2] + tot[1] + sgt[0]; \
        R += tot[0] + tot[1] + tot[2] + tot[3]; \
        _Pragma("unroll") for (int kt = 0; kt < 4; ++kt) { float run = off[kt]; \
            _Pragma("unroll") for (int j = 3; j >= 0; --j) { const float a = fexp2((Lp[kt][j] + run) * LOG2E); run += Lm[kt][j]; s[kt][j] = a; } } \
        const bf16x8 p0 = pack8(s[0], s[1]), p1 = pack8(s[2], s[3]); \
        _Pragma("unroll") for (int dt = 0; dt < 4; ++dt) { o[dt] = mfma16(T.v[dt][0], p0, o[dt]); o[dt] = mfma16(T.v[dt][1], p1, o[dt]); } } while (0)
#define C_DONE() (__builtin_amdgcn_ballot_w64(R > -110.f) == 0ull)
    KV ta, tb;
    C_LOAD(ta, thi);
    for (int tile = thi; tile >= 0; tile -= 2) {
        C_LOAD(tb, tile >= 1 ? tile - 1 : 0);
        C_STEP(ta, tile);
        if (tile < 1 || C_DONE()) break;
        C_LOAD(ta, tile >= 2 ? tile - 2 : 0);
        C_STEP(tb, tile - 1);
        if (C_DONE()) break;
    }
#undef C_LOAD
#undef C_STEP
#undef C_DONE
    store_o((bf16_t*)(mb + MB_O) + ((size_t)hb * S + tq) * 1280 + 896 + head * 64, o, g);
}


__device__ __forceinline__ void attn_B_unit(const unsigned char* mb, const unsigned char* ws, int hb, int gk, int qt, int w, int lane, LAS float* sc, LAS unsigned char* ldsb, const float* cs) {
    const int g = lane >> 4, li = lane & 15, qi = li >> 2, hh = li & 3;
    const int ql = 4 * w + qi, tq = 32 * qt + ql, h = gk * 4 + hh;
    const int tmin = 32 * qt + 4 * w, tmax = tmin + 3;
    const size_t tau = (size_t)hb * S + tq;
    const float* gb = (const float*)(mb + MB_GB) + tau * 24 + h * 3;
    const float g0 = gb[0], g1 = gb[1], g2 = gb[2];
    f32x4 res[4];
    const int tid = w * 64 + lane;
    const bf16_t* Qp = (const bf16_t*)(mb + MB_QB) + (size_t)(hb * 8 + h) * E + (size_t)tq * 64;
    bf16x8 qraw[2]; qraw[0] = ld16(Qp + 8 * g); qraw[1] = ld16(Qp + 32 + 8 * g);
    f32x4 cv[4]; { const f32x4* c4 = (const f32x4*)(cs + (tau << 4)); cv[0] = c4[0]; cv[1] = c4[1]; cv[2] = c4[2]; cv[3] = c4[3]; }
    Stg r0; stg_load(r0, (const bf16_t*)(mb + MB_KV + 2 * 4 * MiB) + (size_t)(hb * 2 + gk) * E, (const bf16_t*)(mb + MB_KV + 3 * 4 * MiB) + (size_t)(hb * 2 + gk) * E, 0, tid);
    {
        bf16x8 qf[2]; qf[0] = qraw[0]; qf[1] = qraw[1];
        const bf16_t* kc = (const bf16_t*)(ws + WS_KC) + (size_t)(hb * 2 + gk) * 256 * 64;
        const bf16_t* vct = (const bf16_t*)(ws + WS_KC + 512 * 1024) + (size_t)(hb * 2 + gk) * 64 * 256;
        const int cmaxw = tmax >= 31 ? (tmax - 31) >> 4 : -1;
        const int n16 = (cmaxw >> 4) + 1;
        const int cq = tq >= 31 ? (tq - 31) >> 4 : -1;
        f32x4 sa[16];
#pragma unroll
        for (int kt = 0; kt < 16; ++kt) {
            sa[kt] = (f32x4){0.f, 0.f, 0.f, 0.f};
            if (kt < n16) { const bf16_t* kr = kc + (size_t)(16 * kt + li) * 64; sa[kt] = mfma16(ld16(kr + 8 * g), qf[0], sa[kt]); sa[kt] = mfma16(ld16(kr + 32 + 8 * g), qf[1], sa[kt]); }
        }
        const float C2 = 0.125f * LOG2E;
        float mx = -1e30f;
#pragma unroll
        for (int kt = 0; kt < 16; ++kt)
#pragma unroll
            for (int j = 0; j < 4; ++j) if (kt < n16) { const float v = (16 * kt + 4 * g + j <= cq) ? sa[kt][j] * C2 : -1e30f; sa[kt][j] = v; mx = fmaxf(mx, v); }
        mx = fmaxf(mx, shx(mx, 16, lane)); mx = fmaxf(mx, shx(mx, 32, lane));
        float ps = 0.f;
#pragma unroll
        for (int kt = 0; kt < 16; ++kt)
#pragma unroll
            for (int j = 0; j < 4; ++j) if (kt < n16) { const float p = (sa[kt][j] > -1e29f) ? fexp2(sa[kt][j] - mx) : 0.f; sa[kt][j] = p; ps += p; }
        ps += shx(ps, 16, lane); ps += shx(ps, 32, lane);
        const float inv = ps > 0.f ? 1.f / ps : 0.f;
#pragma unroll
        for (int kt = 0; kt < 16; ++kt) if (kt < n16) sa[kt] = sa[kt] * inv;
        f32x4 o[4];
#pragma unroll
        for (int i = 0; i < 4; ++i) o[i] = (f32x4){0.f, 0.f, 0.f, 0.f};
#pragma unroll
        for (int c = 0; c < 8; ++c)
            if (2 * c < n16) { const bf16x8 pf = pack8(sa[2 * c], sa[2 * c + 1]);
#pragma unroll
                for (int dt = 0; dt < 4; ++dt) o[dt] = mfma16(ld16(vct + (size_t)(16 * dt + li) * 256 + c * 32 + 8 * g), pf, o[dt]);
                }
#pragma unroll
        for (int i = 0; i < 4; ++i) res[i] = o[i] * g0;
#pragma unroll
        for (int kt = 0; kt < 16; ++kt)
            if (kt < n16) {
#pragma unroll
                for (int j = 0; j < 4; ++j) { float v = sa[kt][j]; v += qx1(v); v += qx2(v); sa[kt][j] = v; } }
        float nx[17];
#pragma unroll
        for (int kt = 0; kt < 16; ++kt) nx[kt] = shi(sa[kt][0], (lane + 16) & 63);
        nx[16] = 0.f;
#pragma unroll
        for (int kt = 0; kt < 16; ++kt) { const float scv = sa[kt][0] + 2.f * (sa[kt][1] + sa[kt][2] + sa[kt][3]) + (g < 3 ? nx[kt] : nx[kt + 1]);
            if (hh == 0) sc[ql * 64 + 4 * kt + g] = scv; }
    }
    __syncthreads();
    unsigned long long mk0, mk1, mk2, mk3;
    {
        unsigned long long mks[4];
#pragma unroll
        for (int q2 = 0; q2 < 4; ++q2) {
            const int t = 32 * qt + 4 * w + q2, cur = t >> 6, j = lane;
            float v = sc[(4 * w + q2) * 64 + j];
            const bool forced = (j == 0) || (j == cur) || (j == cur - 1);
            v = forced ? 1e4f : ((j <= cur) ? v : -1.f);
            int rank = 0;
            const int jend = (tmax >> 6) + 1;
#pragma unroll 4
            for (int jj = 0; jj < jend; ++jj) { const float ov = __builtin_bit_cast(float, __builtin_amdgcn_readlane(__builtin_bit_cast(int, v), jj)); rank += ((ov > v) || (ov == v && jj < j)) ? 1 : 0; }
            mks[q2] = __ballot(rank < 16);
        }
        mk0 = mks[0]; mk1 = mks[1]; mk2 = mks[2]; mk3 = mks[3];
    }
    LAS unsigned long long* umw = (LAS unsigned long long*)(ldsb + 8192);
    if (lane == 0) umw[w] = mk0 | mk1 | mk2 | mk3;
    __syncthreads();
    int li_l = lane & 15, g_l = lane >> 4; asm volatile("" : "+v"(li_l), "+v"(g_l));
    const unsigned long long selm = qi == 0 ? mk0 : (qi == 1 ? mk1 : (qi == 2 ? mk2 : mk3));
    const unsigned long long um = mk0 | mk1 | mk2 | mk3;
    bf16x8 qf[2];
    {
        qf[1] = qraw[1];
        u32x4 qw = __builtin_bit_cast(u32x4, qraw[0]); float x[8];
        x[0] = bflo(qw.x); x[1] = bfhi(qw.x); x[2] = bflo(qw.y); x[3] = bfhi(qw.y); x[4] = bflo(qw.z); x[5] = bfhi(qw.z); x[6] = bflo(qw.w); x[7] = bfhi(qw.w);
#pragma unroll
        for (int e = 0; e < 8; ++e) { const float other = shx(x[e], 16, lane); const float co = cv[e >> 2][e & 3], si = cv[2 + (e >> 2)][e & 3];
            x[e] = (g_l == 0) ? (x[e] * co - other * si) : ((g_l == 1) ? (x[e] * co + other * si) : x[e]); }
        qw.x = pk_bf16(x[0], x[1]); qw.y = pk_bf16(x[2], x[3]); qw.z = pk_bf16(x[4], x[5]); qw.w = pk_bf16(x[6], x[7]);
        qf[0] = __builtin_bit_cast(bf16x8, qw);
    }
    LAS bf16_t* tb0 = (LAS bf16_t*)(ldsb + 16384); LAS bf16_t* tb1 = tb0 + 9216;
    unsigned long long bum = 0ull;
#pragma unroll
    for (int i = 0; i < 8; ++i) bum |= umw[i];
    const int kbhi_b = (32 * qt + 31) >> 6;
    {
        const bf16_t* K = (const bf16_t*)(mb + MB_KV + 2 * 4 * MiB) + (size_t)(hb * 2 + gk) * E;
        const bf16_t* Vt = (const bf16_t*)(mb + MB_KV + 3 * 4 * MiB) + (size_t)(hb * 2 + gk) * E;
        AState st; st_init(st);
        unsigned long long rem = bum & ((kbhi_b >= 63) ? ~0ull : ((2ull << kbhi_b) - 1ull));
        int kb = 0, cur = 0; bool have = rem != 0ull;
        if (have) { kb = __builtin_ctzll(rem); rem &= rem - 1ull; stg_store(r0, tb0, tid); }
        __syncthreads();
        while (have) {
            const bool hn = rem != 0ull; int kbn = 0; Stg rn;
            if (hn) { kbn = __builtin_ctzll(rem); rem &= rem - 1ull; stg_load(rn, K, Vt, kbn, tid); }
            if ((um >> kb) & 1ull) {
                KV t; lds_frags(t, cur ? tb1 : tb0, li_l, g_l);
                f32x4 s[4]; qk_compute(s, t, qf);
                if (kb > 0 && 64 * kb + 63 <= tmin) {
                    softmax_pv_nomask(st, s, ((selm >> kb) & 1ull) ? 0.f : -1e30f, t.v, lane);
                } else {
                    unsigned vm = 0;
                    if ((selm >> kb) & 1ull) {
#pragma unroll
                        for (int kt = 0; kt < 4; ++kt)
#pragma unroll
                            for (int j = 0; j < 4; ++j) if (64 * kb + 16 * kt + 4 * g_l + j <= tq) vm |= 1u << (kt * 4 + j);
                    }
                    softmax_pv(st, s, vm, t.v, lane);
                }
            }
            if (hn) stg_store(rn, cur ? tb0 : tb1, tid);
            __syncthreads();
            cur ^= 1; kb = kbn; have = hn;
        }
        const float inv = st_inv_l(st, lane) * g1;
#pragma unroll
        for (int i = 0; i < 4; ++i) res[i] += st.o[i] * inv;
    }
    {
        const bf16_t* K = (const bf16_t*)(mb + MB_KV + 4 * 4 * MiB) + (size_t)(hb * 2 + gk) * E;
        const bf16_t* Vt = (const bf16_t*)(mb + MB_KV + 5 * 4 * MiB) + (size_t)(hb * 2 + gk) * E;
        AState st; st_init(st);
        const int kblo = (32 * qt > 511 ? 32 * qt - 511 : 0) >> 6;
        int cur = 0;
        { Stg r; stg_load(r, K, Vt, kblo, tid); stg_store(r, tb0, tid); }
        __syncthreads();
        for (int kb = kblo; kb <= kbhi_b; ++kb) {
            const bool hn = kb < kbhi_b; Stg rn;
            if (hn) stg_load(rn, K, Vt, kb + 1, tid);
            {
                KV t; lds_frags(t, cur ? tb1 : tb0, li_l, g_l);
                f32x4 s[4]; qk_compute(s, t, qf);
                if (64 * kb >= tmax - 511 && 64 * kb + 63 <= tmin) {
                    softmax_pv_nomask(st, s, 0.f, t.v, lane);
                } else {
                    unsigned vm = 0;
#pragma unroll
                    for (int kt = 0; kt < 4; ++kt)
#pragma unroll
                        for (int j = 0; j < 4; ++j) { const int dist = tq - (64 * kb + 16 * kt + 4 * g_l + j); if (dist >= 0 && dist <= 511) vm |= 1u << (kt * 4 + j); }
                    softmax_pv(st, s, vm, t.v, lane);
                }
            }
            if (hn) stg_store(rn, cur ? tb0 : tb1, tid);
            __syncthreads();
            cur ^= 1;
        }
        const float inv = st_inv_l(st, lane) * g2;
#pragma unroll
        for (int i = 0; i < 4; ++i) res[i] += st.o[i] * inv;
    }
    store_o((bf16_t*)(mb + MB_O) + tau * 1280 + 384 + h * 64, res, g);
}

__device__ __forceinline__ void compress_block(const unsigned char* mb, unsigned char* ws, int kv, int hb, int gk, int rb, int w, int lane, LAS bf16_t* hid) {
    const int g = lane >> 4, li = lane & 15;
    const bf16_t* src = (const bf16_t*)(mb + MB_KV + (size_t)kv * 4 * MiB) + (size_t)(hb * 2 + gk) * E;
    const bf16_t* W1t = (const bf16_t*)(ws + WS_CW1) + (size_t)kv * 128 * 2048 + (size_t)(16 * w + li) * 2048 + 8 * g;
    const bf16_t* W2t = (const bf16_t*)(ws + WS_CW2) + (size_t)kv * 64 * 128;
    const float* bias = (const float*)(ws + WS_CW2 + 65536) + kv * 128;
    const int row = 16 * rb + li;
    f32x4 hacc = {0.f, 0.f, 0.f, 0.f};
#pragma unroll 8
    for (int lt = 0; lt < 32; ++lt) {
        int tok = 16 * row + lt; tok = tok < S ? tok : S - 1;
        const bf16_t* xr = src + (size_t)tok * 64 + 8 * g;
        hacc = mfma16(ld16(W1t + lt * 64), ld16(xr), hacc);
        hacc = mfma16(ld16(W1t + lt * 64 + 32), ld16(xr + 32), hacc);
    }
    float hv[4];
#pragma unroll
    for (int j = 0; j < 4; ++j) { const float x = hacc[j] + bias[16 * w + 4 * g + j];
        const float y = 0.7978845608028654f * (x + 0.044715f * x * x * x);
        const float th = 1.f - 2.f * frcp(fexp2(2.f * y * LOG2E) + 1.f);
        hv[j] = 0.5f * x * (1.f + th); }
    { u32x2 wv; wv.x = pk_bf16(hv[0], hv[1]); wv.y = pk_bf16(hv[2], hv[3]); *(LAS u32x2*)(hid + li * 136 + 16 * w + 4 * g) = wv; }
    __syncthreads();
    if (w < 4) {
        const int dt = w;
        f32x4 o = {0.f, 0.f, 0.f, 0.f};
#pragma unroll
        for (int c = 0; c < 4; ++c) {
            const u32x2 plo = *(const LAS u32x2*)(hid + li * 136 + 32 * c + 4 * g), phi = *(const LAS u32x2*)(hid + li * 136 + 32 * c + 16 + 4 * g);
            u32x4 pv; pv.x = plo.x; pv.y = plo.y; pv.z = phi.x; pv.w = phi.y;
            const bf16_t* wr_ = W2t + (size_t)(16 * dt + li) * 128 + 32 * c + 4 * g;
            const u32x2 lo = *(const u32x2*)wr_, hi = *(const u32x2*)(wr_ + 16);
            u32x4 wv; wv.x = lo.x; wv.y = lo.y; wv.z = hi.x; wv.w = hi.y;
            o = mfma16(__builtin_bit_cast(bf16x8, wv), __builtin_bit_cast(bf16x8, pv), o);
        }
        if (kv == 0) { bf16_t* kc = (bf16_t*)(ws + WS_KC) + (size_t)(hb * 2 + gk) * 256 * 64 + (size_t)row * 64 + 16 * dt + 4 * g;
            u32x2 wv; wv.x = pk_bf16(o[0], o[1]); wv.y = pk_bf16(o[2], o[3]); *(u32x2*)kc = wv; }
        else { bf16_t* vct = (bf16_t*)(ws + WS_KC + 512 * 1024) + (size_t)(hb * 2 + gk) * 64 * 256 + perm32pos(row);
#pragma unroll
            for (int j = 0; j < 4; j += 2) { const unsigned wv = pk_bf16(o[j], o[j + 1]); vct[(size_t)(16 * dt + 4 * g + j) * 256] = (bf16_t)(wv & 0xffffu); vct[(size_t)(16 * dt + 4 * g + j + 1) * 256] = (bf16_t)(wv >> 16); } }
    }
    __syncthreads();
}

__device__ __forceinline__ void transpose_wave(const bf16_t* src, bf16_t* dst, int dl, int pb, bf16_t* tile, int lane) {
    const int L = S >> dl, pstart = 64 * pb, rho = pstart >> (12 - dl), mk0 = pstart & (L - 1);
#pragma unroll
    for (int i = 0; i < 8; ++i) { const int key = 8 * i + (lane >> 3); const int tok = rho + ((mk0 + key) << dl);
        *(bf16x8*)(tile + key * 72 + 8 * (lane & 7)) = ld16(src + (size_t)tok * 64 + 8 * (lane & 7)); }
    asm volatile("s_waitcnt vmcnt(0) lgkmcnt(0)" ::: "memory");
#pragma unroll
    for (int i = 0; i < 8; ++i) { const int o = lane + 64 * i, d = o >> 3, grp = o & 7, kb0 = 32 * (grp >> 2) + 4 * (grp & 3);
        unsigned short v[8];
#pragma unroll
        for (int e = 0; e < 8; ++e) v[e] = tile[(kb0 + (e < 4 ? e : 12 + e)) * 72 + d];
        u32x4 w; w.x = v[0] | ((unsigned)v[1] << 16); w.y = v[2] | ((unsigned)v[3] << 16); w.z = v[4] | ((unsigned)v[5] << 16); w.w = v[6] | ((unsigned)v[7] << 16);
        *(u32x4*)(dst + (size_t)d * S + pstart + 8 * grp) = w; }
    asm volatile("s_waitcnt lgkmcnt(0)" ::: "memory");
}

__device__ __forceinline__ float wave_sum(float v, int lane) {
#pragma unroll
    for (int o = 1; o < 64; o <<= 1) v += shx(v, o, lane);
    return v;
}
__device__ __forceinline__ void norm_rows_bf16(const float* src, const float* gain, bf16_t* dst, int gw, int ngw, int lane) {
    f32x4 gv[4];
#pragma unroll
    for (int j = 0; j < 4; ++j) gv[j] = *(const f32x4*)(gain + 4 * lane + 256 * j);
    for (int row0 = gw; row0 < T; row0 += 4 * ngw) {
        f32x4 v[4][4]; float ss[4];
#pragma unroll
        for (int r = 0; r < 4; ++r) { const int row = row0 + r * ngw; const float* xr = src + (size_t)(row < T ? row : row0) * D + 4 * lane; ss[r] = 0.f;
#pragma unroll
            for (int j = 0; j < 4; ++j) { v[r][j] = *(const f32x4*)(xr + 256 * j); ss[r] += (v[r][j][0] * v[r][j][0] + v[r][j][1] * v[r][j][1]) + (v[r][j][2] * v[r][j][2] + v[r][j][3] * v[r][j][3]); } }
#pragma unroll
        for (int o = 1; o < 64; o <<= 1) {
#pragma unroll
            for (int r = 0; r < 4; ++r) ss[r] += shx(ss[r], o, lane); }
#pragma unroll
        for (int r = 0; r < 4; ++r) { const int row = row0 + r * ngw; if (row < T) { const float rstd = 1.f / sqrtf(ss[r] * (1.f / D) + 1e-6f);
            bf16_t* orow = dst + (size_t)row * D + 4 * lane;
#pragma unroll
            for (int j = 0; j < 4; ++j) { const f32x4 y = v[r][j] * rstd * gv[j]; u32x2 w; w.x = pk_bf16(y[0], y[1]); w.y = pk_bf16(y[2], y[3]); *(u32x2*)(orow + 256 * j) = w; } } }
    }
}
__device__ __forceinline__ void norm_rows_f32_inplace(float* buf, const float* gain, int gw, int ngw, int lane) {
    f32x4 gv[4];
#pragma unroll
    for (int j = 0; j < 4; ++j) gv[j] = *(const f32x4*)(gain + 4 * lane + 256 * j);
    for (int row = gw; row < T; row += ngw) {
        float* xr = buf + (size_t)row * D + 4 * lane; f32x4 v[4]; float ss = 0.f;
#pragma unroll
        for (int j = 0; j < 4; ++j) { v[j] = *(const f32x4*)(xr + 256 * j); ss += (v[j][0] * v[j][0] + v[j][1] * v[j][1]) + (v[j][2] * v[j][2] + v[j][3] * v[j][3]); }
        const float rstd = 1.f / sqrtf(wave_sum(ss, lane) * (1.f / D) + 1e-6f);
#pragma unroll
        for (int j = 0; j < 4; ++j) *(f32x4*)(xr + 256 * j) = v[j] * rstd * gv[j];
    }
}
__device__ __forceinline__ void tr_item(const float* base, int nvalid, int ld, int k0, bf16_t* WT, int K, int n0, float* scr, int lane) {
    const int g4 = lane & 7;
#pragma unroll
    for (int i = 0; i < 8; ++i) { const int kk = 8 * i + (lane >> 3);
        f32x4 v = {0.f, 0.f, 0.f, 0.f};
        if (4 * g4 < nvalid) v = *(const f32x4*)(base + (size_t)(k0 + kk) * ld + 4 * g4);
        float* d = scr + kk * 33 + 4 * g4; d[0] = v[0]; d[1] = v[1]; d[2] = v[2]; d[3] = v[3]; }
    asm volatile("s_waitcnt lgkmcnt(0)" ::: "memory");
    const int c = lane & 7;
#pragma unroll
    for (int j = 0; j < 4; ++j) { const int n = (lane >> 3) + 8 * j; const float* s = scr + (8 * c) * 33 + n;
        u32x4 o; o.x = pk_bf16(s[0 * 33], s[1 * 33]); o.y = pk_bf16(s[2 * 33], s[3 * 33]); o.z = pk_bf16(s[4 * 33], s[5 * 33]); o.w = pk_bf16(s[6 * 33], s[7 * 33]);
        *(u32x4*)(WT + (size_t)(n0 + n) * K + k0 + 8 * c) = o; }
    asm volatile("s_waitcnt lgkmcnt(0)" ::: "memory");
}
__device__ __forceinline__ void conv_ffn(const float* w1, const float* w3, const float* w2, unsigned char* ws, float* scr, int gw, int ngw, int lane) {
    constexpr int I13 = 16 * 176, I2 = 44 * 32;
    bf16_t* W13t = (bf16_t*)(ws + WS_W13); bf16_t* W2t = (bf16_t*)(ws + WS_W2);
    for (int it = gw; it < I13 + I2; it += ngw) {
        if (it < I13) { const int kb = it / 176, nb = it % 176, n = 32 * nb, j = 128 * (n >> 8) + (n & 127);
            tr_item(((n & 255) < 128 ? w1 : w3) + j, 32, FF, 64 * kb, W13t, D, 32 * nb, scr, lane); }
        else { const int r = it - I13, kb = r / 32, nb = r % 32; tr_item(w2 + 32 * nb, 32, D, 64 * kb, W2t, FF, 32 * nb, scr, lane); }
    }
}
__device__ __forceinline__ void conv_mixer(const float* w_in, const float* w_gate, const float* w_up, const float* w_out, const float* cw1k, const float* cw2k, const float* cw1v, const float* cw2v,
                                           const float* pek, const float* pev, unsigned char* ws, float* scr, int gw, int ngw, int lane) {
    constexpr int I_IN = 16 * 288, I_UP0 = 6 * 32, I_UP1 = 8 * 32, I_UP2 = 6 * 32, I_OUT = 16 * 32, I_C1 = 32 * 4, I_C2 = 2 * 2, I_B = 8;
    constexpr int NI = I_IN + I_UP0 + I_UP1 + I_UP2 + I_OUT + 2 * I_C1 + 2 * I_C2 + I_B;
    for (int it = gw; it < NI; it += ngw) {
        int r = it;
        if (r < I_IN) { const int kb = r / 288, nb = r % 288, n = 32 * nb; const float* base = w_in; int nvalid = 0;
            if (n >= NPROJ) { base = w_gate + (n - NPROJ); nvalid = 32; }
            else if ((n >> 6) == 74) { if ((n & 63) == 0) { base = w_in + 4736; nvalid = 24; } }
            else { const int oc = in_orig_col(n); if (oc >= 0) { base = w_in + oc; nvalid = 32; } }
            tr_item(base, nvalid, n >= NPROJ ? 3072 : 5912, 64 * kb, (bf16_t*)(ws + WS_WIN), D, 32 * nb, scr, lane); continue; }
        r -= I_IN;
        if (r < I_UP0) { const int kb = r / 32, nb = r % 32; tr_item(w_up + 32 * nb, 32, D, 64 * kb, (bf16_t*)(ws + WS_WUP), 384, 32 * nb, scr, lane); continue; }
        r -= I_UP0;
        if (r < I_UP1) { const int kb = r / 32, nb = r % 32; tr_item(w_up + (size_t)384 * D + 32 * nb, 32, D, 64 * kb, (bf16_t*)(ws + WS_WUP) + 1024 * 384, 512, 32 * nb, scr, lane); continue; }
        r -= I_UP1;
        if (r < I_UP2) { const int kb = r / 32, nb = r % 32; tr_item(w_up + (size_t)896 * D + 32 * nb, 32, D, 64 * kb, (bf16_t*)(ws + WS_WUP) + 1024 * 896, 384, 32 * nb, scr, lane); continue; }
        r -= I_UP2;
        if (r < I_OUT) { const int kb = r / 32, nb = r % 32; tr_item(w_out + 32 * nb, 32, D, 64 * kb, (bf16_t*)(ws + WS_WOUT), D, 32 * nb, scr, lane); continue; }
        r -= I_OUT;
        if (r < 2 * I_C1) { const int kv = r / I_C1, q = r % I_C1, kb = q / 4, nb = q % 4; tr_item((kv ? cw1v : cw1k) + 32 * nb, 32, 128, 64 * kb, (bf16_t*)(ws + WS_CW1) + (size_t)kv * 128 * 2048, 2048, 32 * nb, scr, lane); continue; }
        r -= 2 * I_C1;
        if (r < 2 * I_C2) { const int kv = r / I_C2, q = r % I_C2, kb = q / 2, nb = q % 2; tr_item((kv ? cw2v : cw2k) + 32 * nb, 32, 64, 64 * kb, (bf16_t*)(ws + WS_CW2) + (size_t)kv * 64 * 128, 128, 32 * nb, scr, lane); continue; }
        r -= 2 * I_C2;
        {
            const int kv = r >> 2, n = 32 * (r & 3) + (lane & 31); const float* pe = kv ? pev : pek; const float* w1 = kv ? cw1v : cw1k; float a = 0.f;
            for (int kq = (lane >> 5); kq < 2048; kq += 2) a += pe[kq] * w1[(size_t)kq * 128 + n];
            a += shx(a, 32, lane);
            if (lane < 32) ((float*)(ws + WS_CW2 + 65536))[kv * 128 + n] = a;
        }
    }
}

#ifndef DUP
#define DUP 0
#endif
#ifndef NHF
#define NHF 2
#endif
#ifndef PHM
#define PHM 0xFFFF
#endif
struct Params { const float* in[22]; float* out; unsigned char* ws; };

#define BW_XC(j) (2048 + 64 * (j))
#define BW_XS(j) (2560 + 64 * (j))
#define BW_XG(j) (3072 + 64 * (j))
#define BW_TOP 3584
#define BW_TG 3648
__device__ __forceinline__ unsigned bw_ld(unsigned* p) { return __hip_atomic_load(p, __ATOMIC_RELAXED, __HIP_MEMORY_SCOPE_AGENT); }
__device__ __forceinline__ unsigned bw_add(unsigned* p) { return __hip_atomic_fetch_add(p, 1u, __ATOMIC_RELAXED, __HIP_MEMORY_SCOPE_AGENT); }
__device__ __forceinline__ void grid_bar2(unsigned* ctl, unsigned n, bool leader) {
    asm volatile("s_waitcnt vmcnt(0) lgkmcnt(0)" ::: "memory");
    __syncthreads();
    if (leader) {
        const unsigned x = (unsigned)__builtin_amdgcn_s_getreg((3 << 11) | 20) & 7u;
        const unsigned nloc = bw_ld(ctl + BW_XC(x));
        unsigned nx = 0;
#pragma unroll
        for (int j = 0; j < 8; ++j) nx += bw_ld(ctl + BW_XC(j)) != 0u ? 1u : 0u;
        const unsigned old = bw_add(ctl + BW_XS(x));
        if (old + 1u == n * nloc) {
            __builtin_amdgcn_fence(__ATOMIC_RELEASE, "agent");
            asm volatile("s_waitcnt vmcnt(0)" ::: "memory");
            const unsigned og = bw_add(ctl + BW_TOP);
            if (og + 1u == n * nx) bw_add(ctl + BW_TG);
            else while (bw_ld(ctl + BW_TG) < n) __builtin_amdgcn_s_sleep(2);
            bw_add(ctl + BW_XG(x));
        } else {
            while (bw_ld(ctl + BW_XG(x)) < n) __builtin_amdgcn_s_sleep(2);
        }
        __builtin_amdgcn_fence(__ATOMIC_ACQUIRE, "agent");
        asm volatile("s_waitcnt vmcnt(0)" ::: "memory");
    }
    __syncthreads();
}
__global__ void __launch_bounds__(NTHREADS, 2) hybrid_fwd(Params p) {
    extern __shared__ __attribute__((aligned(16))) unsigned char lds_raw[];
    cg::grid_group grid = cg::this_grid();
    LAS unsigned char* lds = (LAS unsigned char*)lds_raw;
    const int G0 = gridDim.x;
    unsigned nbar = 0;
#define GBAR() do { ++nbar; int l_; asm volatile("v_mbcnt_lo_u32_b32 %0, -1, 0\n\tv_mbcnt_hi_u32_b32 %0, -1, %0" : "=v"(l_)); unsigned char* w_ = p.ws; asm volatile("" : "+s"(w_)); grid_bar2((unsigned*)(w_ + WS_CTL), nbar, wave0 == 0 && l_ == 0); } while (0)
#define GSYNC() GBAR()
    const int wave0 = __builtin_amdgcn_readfirstlane(threadIdx.x >> 6);
#define PH int G = G0; asm volatile("" : "+s"(G)); const int ngw = G * NWAVES; (void)ngw; int lane_; asm volatile("v_mbcnt_lo_u32_b32 %0, -1, 0\n\tv_mbcnt_hi_u32_b32 %0, -1, %0" : "=v"(lane_)); int bid_ = blockIdx.x; int wave_ = wave0; asm volatile("" : "+s"(bid_), "+s"(wave_)); const int lane = lane_, wave = wave_, tid = wave * 64 + lane, gw = bid_ * NWAVES + wave; (void)tid; \
    unsigned char* ws = p.ws; float* out = p.out; asm volatile("" : "+s"(ws), "+s"(out)); \
    float* scr = (float*)(lds_raw + wave * 16384); unsigned char* mb = ws + WS_R; bf16_t* U = (bf16_t*)(ws + WS_U); bf16_t* ACT = (bf16_t*)(ws + WS_R); \
    (void)lane; (void)gw; (void)scr; (void)mb; (void)U; (void)ACT;

    if (threadIdx.x == 0) { const unsigned x = (unsigned)__builtin_amdgcn_s_getreg((3 << 11) | 20) & 7u; bw_add((unsigned*)(p.ws + WS_CTL) + BW_XC(x)); }
    {
        PH
        float* cs = (float*)(ws + WS_CS);
        const int* pos = (const int*)p.in[1];
        for (int i = bid_ * NTHREADS + tid; i < T * 8; i += G * NTHREADS) {
            const int tok = i >> 3, f = i & 7;
            const float ang = (float)pos[tok] * ROPE_INV[f];
            double rev = (double)ang * 0.15915494309189535; rev -= floor(rev);
            const float rf = (float)rev;
            cs[(size_t)tok * 16 + f] = __builtin_amdgcn_cosf(rf); cs[(size_t)tok * 16 + 8 + f] = __builtin_amdgcn_sinf(rf);
        }
    }

    for (int layer = 0; layer < DEPTH; ++layer) {
        { PH
          if (PHM & 1) conv_ffn(p.in[3] + (size_t)layer * D * FF, p.in[4] + (size_t)layer * D * FF, p.in[5] + (size_t)layer * FF * D, ws, scr, gw, ngw, lane);
          if (PHM & 1) norm_rows_bf16(layer == 0 ? p.in[0] : out, p.in[2] + layer * D, U, gw, ngw, lane); }
        if (layer == 0) grid.sync(); else GBAR();
        { PH
          for (int rep = 0; rep < ((DUP & 1) ? 2 : 1); ++rep) { EpiFfnUp Ep{ACT}; run_gemm(lds, U, D, (const bf16_t*)(ws + WS_W13), T, 2 * FF, D, Ep, wave); } }
        GSYNC();
        { PH
          if (PHM & 4) { EpiResid Ep{layer == 0 ? p.in[0] : out, out, 0.5f}; run_gemm(lds, ACT, FF, (const bf16_t*)(ws + WS_W2), T, D, FF, Ep, wave); } }
        GSYNC();
        { PH
          if (PHM & 8) conv_mixer(p.in[7] + (size_t)layer * D * 5912, p.in[14] + (size_t)layer * D * 3072, p.in[15] + (size_t)layer * 1280 * D, p.in[16] + (size_t)layer * D * D,
                   p.in[9] + (size_t)layer * 2048 * 128, p.in[10] + (size_t)layer * 128 * 64, p.in[12] + (size_t)layer * 2048 * 128, p.in[13] + (size_t)layer * 128 * 64,
                   p.in[8] + (size_t)layer * 2048, p.in[11] + (size_t)layer * 2048, ws, scr, gw, ngw, lane);
          norm_rows_bf16(out, p.in[6] + layer * D, U, gw, ngw, lane); }
        GSYNC();
        for (int hf = 0; hf < NHF; ++hf) {
            { PH
              for (int rep = 0; rep < ((DUP & 2) ? 2 : 1); ++rep) { EpiInProj Ep{mb, (const float*)(ws + WS_CS) + (size_t)hf * TH * 16}; run_gemm(lds, U + (size_t)hf * TH * D, D, (const bf16_t*)(ws + WS_WIN), TH, NIN, D, Ep, wave); } }
            GSYNC();
            { PH
              if ((PHM & 0x1C0) != 0x1C0) { u32x4* Oz = (u32x4*)(mb + MB_O); for (size_t i = (size_t)bid_ * NTHREADS + tid; i < (size_t)TH * 1280 / 8; i += (size_t)G * NTHREADS) Oz[i] = (u32x4){0u, 0u, 0u, 0u}; }
              for (int it = gw; it < 7168; it += ngw) {
                  const unsigned char* sb; unsigned char* db; int dl = 0, hi, pb = it & 63; const int q = it >> 6;
                  if (q < 72) { const int g3 = q / 24; hi = q % 24; sb = mb + MB_VRM + (size_t)g3 * 12 * MiB; db = mb + MB_VA + (size_t)g3 * 12 * MiB; dl = 2 * g3; }
                  else if (q < 80) { hi = q - 72; sb = mb + MB_VRM + 36 * MiB; db = mb + MB_KV + 3 * 4 * MiB; }
                  else if (q < 88) { hi = q - 80; sb = mb + MB_VRM + 40 * MiB; db = mb + MB_KV + 5 * 4 * MiB; }
                  else { hi = q - 88; sb = mb + MB_VRM + 44 * MiB; db = mb + MB_VC; }
                  transpose_wave((const bf16_t*)sb + (size_t)hi * E, (bf16_t*)db + (size_t)hi * E, dl, pb, (bf16_t*)scr, lane);
              }
              for (int it = bid_; it < 256; it += G) { const int kv = it >> 7, hb = (it >> 5) & 3, gk = (it >> 4) & 1, rb = it & 15; compress_block(mb, ws, kv, hb, gk, rb, wave, lane, (LAS bf16_t*)(lds + 125952)); } }
            GSYNC();
            {
                PH
                LAS unsigned* sidx = (LAS unsigned*)(lds + LDS_MISC);
                const int xcd = bid_ & 7;
                unsigned* ctr = (unsigned*)(ws + WS_CTL) + ((layer * 2 + hf) * 8 + xcd) * 64;
                LAS float* sc = (LAS float*)lds;
                unsigned nxt = 0u; if (tid == 0) nxt = atomicAdd(ctr, 1u);
                for (;;) {
                    __syncthreads();
                    if (tid == 0) *sidx = nxt;
                    __syncthreads();
                    const int idx = (int)*sidx;
                    if (idx >= 320) break;
                    if (tid == 0) nxt = atomicAdd(ctr, 1u);
                    int ln = lane; asm volatile("" : "+v"(ln));
                    if (idx < 128) { const int qt = 127 - idx; attn_B_unit(mb, ws, xcd >> 1, xcd & 1, qt, wave, ln, sc, lds, (const float*)(ws + WS_CS) + (size_t)hf * TH * 16); }
                    else if (idx < 224) { const int i = idx - 128, pr = xcd * 3 + i / 32, j = i % 32; attn_A_wave(mb, pr / 6, pr % 6, j >> 1, (j & 1) * 8 + wave, ln, wave, lds); }
                    else { const int i = idx - 224, pr = xcd * 3 + i / 32, qb = 31 - (i % 32); attn_C_wave(mb, pr / 6, pr % 6, qb, wave, ln); }
                }
            }
            GSYNC();
            { PH
              if (PHM & 512) { EpiUpMerge<true> Ep{(const bf16_t*)(mb + MB_G), (bf16_t*)(mb + MB_Y)}; run_gemm(lds, (const bf16_t*)(mb + MB_O), 1280, (const bf16_t*)(ws + WS_WUP), TH, D, 384, Ep, wave); } }
            { PH
              if (PHM & 512) { EpiUpMerge<false> Ep{(const bf16_t*)(mb + MB_G) + 1024, (bf16_t*)(mb + MB_Y)}; run_gemm(lds, (const bf16_t*)(mb + MB_O) + 384, 1280, (const bf16_t*)(ws + WS_WUP) + 1024 * 384, TH, D, 512, Ep, wave); } }
            { PH
              if (PHM & 512) { EpiUpMerge<false> Ep{(const bf16_t*)(mb + MB_G) + 2048, (bf16_t*)(mb + MB_Y)}; run_gemm(lds, (const bf16_t*)(mb + MB_O) + 896, 1280, (const bf16_t*)(ws + WS_WUP) + 1024 * 896, TH, D, 384, Ep, wave); } }
            GSYNC();
            { PH
              if (PHM & 4) { float* hh = out + (size_t)hf * TH * D; EpiResid Ep{hh, hh, 1.0f}; run_gemm(lds, (const bf16_t*)(mb + MB_Y), D, (const bf16_t*)(ws + WS_WOUT), TH, D, D, Ep, wave); } }
            GSYNC();
        }
        { PH
          if (PHM & 1) conv_ffn(p.in[18] + (size_t)layer * D * FF, p.in[19] + (size_t)layer * D * FF, p.in[20] + (size_t)layer * FF * D, ws, scr, gw, ngw, lane);
          norm_rows_bf16(out, p.in[17] + layer * D, U, gw, ngw, lane); }
        GSYNC();
        { PH
          if (PHM & 2) { EpiFfnUp Ep{ACT}; run_gemm(lds, U, D, (const bf16_t*)(ws + WS_W13), T, 2 * FF, D, Ep, wave); } }
        GSYNC();
        { PH
          if (PHM & 4) { EpiResid Ep{out, out, 0.5f}; run_gemm(lds, ACT, FF, (const bf16_t*)(ws + WS_W2), T, D, FF, Ep, wave); } }
        GSYNC();
    }
    { PH
      norm_rows_f32_inplace(out, p.in[21], gw, ngw, lane); }
}

extern "C" void kernel_launch(void* const* d_in, const int* in_sizes, int n_in, void* d_out, int out_size, void* d_ws, size_t ws_size, hipStream_t stream) {
    static int grid_blocks = 0;
    if (grid_blocks == 0) {
        if (n_in != 22 || out_size != T * D || ws_size < WS_NEED) { fprintf(stderr, "kernel_launch: unexpected shapes (n_in %d out %d ws %zu, need %zu)\n", n_in, out_size, ws_size, (size_t)WS_NEED); grid_blocks = -1; return; }
        int dev = 0, cus = 0, per_cu = 0;
        hipGetDevice(&dev);
        hipDeviceGetAttribute(&cus, hipDeviceAttributeMultiprocessorCount, dev);
        if (hipFuncSetAttribute((const void*)hybrid_fwd, hipFuncAttributeMaxDynamicSharedMemorySize, LDS_BYTES) != hipSuccess) { fprintf(stderr, "kernel_launch: hipFuncSetAttribute failed\n"); grid_blocks = -1; return; }
        hipOccupancyMaxActiveBlocksPerMultiprocessor(&per_cu, (const void*)hybrid_fwd, NTHREADS, LDS_BYTES);
        if (per_cu < 1) { fprintf(stderr, "kernel_launch: occupancy query says %d blocks/CU\n", per_cu); per_cu = 1; }
        (void)hipGetLastError();
        grid_blocks = cus & ~7;
        if (grid_blocks < 8) { fprintf(stderr, "kernel_launch: needs at least 8 CUs\n"); grid_blocks = -1; return; }
    }
    if (grid_blocks < 0) return;
    hipMemsetAsync((char*)d_ws + WS_CTL, 0, 16384, stream);
    Params p{};
    for (int i = 0; i < 22; ++i) p.in[i] = (const float*)d_in[i];
    p.out = (float*)d_out; p.ws = (unsigned char*)d_ws;
    void* args[] = {&p};
    hipError_t e = hipLaunchCooperativeKernel((const void*)hybrid_fwd, dim3(grid_blocks), dim3(NTHREADS), args, LDS_BYTES, stream);
    if (e != hipSuccess) fprintf(stderr, "cooperative launch failed: %s (grid %d)\n", hipGetErrorString(e), grid_blocks);
}
```

```cpp
#include <hip/hip_runtime.h>
#include <hip/hip_cooperative_groups.h>
#include <cstdio>
#include <cstdint>
namespace cg = cooperative_groups;

namespace pg8 {
#define PG8_LAS __attribute__((address_space(3)))
typedef unsigned short bf16_t;
typedef short bf16x8 __attribute__((ext_vector_type(8)));
typedef float f32x4 __attribute__((ext_vector_type(4)));
typedef unsigned u32x4 __attribute__((ext_vector_type(4)));
constexpr int BM = 256, BK = 64, HALF = 128, HTB = HALF * BK * 2  , STAGE_BYTES = 8 * HTB, NXCD = 8, WGM = 8;

__host__ __device__ __forceinline__ int lds_byte(int r, int c) { const int st = (r >> 4) * 2 + (c >> 5), rr = r & 15, cc = c & 31, ob = rr * 64 + cc * 2; return st * 1024 + (ob ^ (((ob >> 9) & 1) << 5)); }
__host__ __device__ __forceinline__ void stage_rc(int b, int& R, int& C) { const int st = b / 1024, sb = b % 1024, swz = sb ^ (((sb >> 9) & 1) << 5); R = (st >> 1) * 16 + swz / 64; C = (st & 1) * 32 + (swz % 64) / 2; }
__host__ __device__ __forceinline__ int perm32(int rho) { const int n = rho >> 4, i = rho & 15; return 8 * (i >> 2) + 4 * n + (i & 3); }

struct Unit { int pm, pn; };
struct Gemm { const bf16_t* A; const bf16_t* Bt; int M, N, K, lda; };

struct StaticOrder {
    int nM, nN, nwg, G, c;
    __host__ __device__ void init(int M, int N, int G_, int c_) { nM = M / BM; nN = N / BM; nwg = nM * nN; G = G_; c = c_; }
    __host__ __device__ bool next(int i, Unit& u) const {
        const long L = (long)i * G + c; if (L >= nwg) return false;
        int wgid = (int)L; { const int q = nwg / NXCD, r = nwg % NXCD, xcd = wgid % NXCD, off = wgid / NXCD; wgid = (xcd < r ? xcd * (q + 1) : r * (q + 1) + (xcd - r) * q) + off; }
        const int nig = WGM * nN, gid = wgid / nig, fm = gid * WGM, gsz = (nM - fm) < WGM ? (nM - fm) : WGM;
        u.pm = fm + ((wgid % nig) % gsz); u.pn = (wgid % nig) / gsz; return true;
    }
    __device__ __forceinline__ void a_ready(const Unit&) const {}
    __device__ __forceinline__ void done(const Unit&) const {}
};

__device__ __forceinline__ unsigned cvt_pk_bf16(float lo, float hi) { unsigned r; asm volatile("v_cvt_pk_bf16_f32 %0, %1, %2" : "=v"(r) : "v"(lo), "v"(hi)); return r; }
typedef float f32x2 __attribute__((ext_vector_type(2)));
template <class Epi, class Sched, bool ALIGN_EPI = false, bool SP2 = false>
__device__ __forceinline__ void gemm_phase(PG8_LAS unsigned char* lds, const Gemm g, const Sched& S, const Epi& E, int wid_in) {
    int lane_l; asm volatile("v_mbcnt_lo_u32_b32 %0, -1, 0\n\tv_mbcnt_hi_u32_b32 %0, -1, %0" : "=v"(lane_l)); int tid_l = wid_in * 64 + lane_l;
    const int tid = tid_l, wid = __builtin_amdgcn_readfirstlane(tid >> 6), lane = tid & 63, wr = wid >> 2, wc = wid & 3, fr = lane & 15, fq = lane >> 4;
    const int K = g.K, nt = K / BK;
    unsigned voffA[2], voffB[2];
#pragma unroll
    for (int i = 0; i < 2; ++i) { int R, C; stage_rc(tid * 16 + i * 8192, R, C); const int Rb = Epi::PERM ? ((R & ~31) + perm32(R & 31)) : R;
        voffA[i] = (unsigned)(R * g.lda + C) * 2u; voffB[i] = (unsigned)(Rb * K + C) * 2u; }
    const size_t kstep = (size_t)(BK * 2);
    const size_t hstepA = (size_t)HALF * g.lda * 2, hstepB = (size_t)HALF * K * 2;
    const size_t tstepA = 2 * hstepA, tstepB = 2 * hstepB;
    const unsigned ldsw = (unsigned)wid * 1024u;
    const int aoff = lds_byte(wr * 64 + fr, fq * 8), boff = lds_byte(wc * 32 + fr, fq * 8);
#define PG8_SA(b, h) (((b) * 2 + (h)) * HTB)
#define PG8_SB(b, h) ((4 + (b) * 2 + (h)) * HTB)
#define PG8_STAGE(bufoff, gbase, voff) do { _Pragma("unroll") for (int _i = 0; _i < 2; ++_i) \
        __builtin_amdgcn_global_load_lds((const unsigned*)((const char*)(gbase) + (voff)[_i]), (PG8_LAS unsigned*)(lds + (bufoff) + ldsw + _i * 8192), 16, 0, 0); } while (0)
#define PG8_LDA(dst, b, h) do { _Pragma("unroll") for (int m = 0; m < 4; ++m) _Pragma("unroll") for (int k = 0; k < 2; ++k) dst[m][k] = *(const PG8_LAS bf16x8*)(lds + PG8_SA(b, h) + aoff + m * 2048 + k * 1024); } while (0)
#define PG8_LDB(dst, b, h) do { _Pragma("unroll") for (int n = 0; n < 2; ++n) _Pragma("unroll") for (int k = 0; k < 2; ++k) dst[n][k] = *(const PG8_LAS bf16x8*)(lds + PG8_SB(b, h) + boff + n * 2048 + k * 1024); } while (0)
#define PG8_MMA(ai, bj, At, Bt) do { __builtin_amdgcn_s_setprio(1); _Pragma("unroll") for (int m = 0; m < 4; ++m) _Pragma("unroll") for (int n = 0; n < 2; ++n) _Pragma("unroll") for (int k = 0; k < 2; ++k) \
        acc[ai][bj][m][n] = __builtin_amdgcn_mfma_f32_16x16x32_bf16(Bt[n][k], At[m][k], acc[ai][bj][m][n], 0, 0, 0); __builtin_amdgcn_s_setprio(0); } while (0)
#define PG8_WAIT_V(n) asm volatile("s_waitcnt vmcnt(" #n ")" ::: "memory")
#define PG8_WAIT_L(n) asm volatile("s_waitcnt lgkmcnt(" #n ")" ::: "memory")
#define PG8_BAR __builtin_amdgcn_s_barrier()
#define PG8_SCHED __builtin_amdgcn_sched_barrier(0)
    Unit cur, nxt; int ui = 0;
    if (!S.next(0, cur)) return;
    f32x4 acc[2][2][4][2];
#pragma unroll
    for (int a = 0; a < 2; ++a)
#pragma unroll
        for (int b = 0; b < 2; ++b)
#pragma unroll
            for (int m = 0; m < 4; ++m)
#pragma unroll
                for (int n = 0; n < 2; ++n) acc[a][b][m][n] = (f32x4){0.f, 0.f, 0.f, 0.f};
    bf16x8 At[4][2], B0[2][2], B1[2][2];
    const char* cA = (const char*)g.A + (size_t)cur.pm * tstepA; const char* cB = (const char*)g.Bt + (size_t)cur.pn * tstepB;
    S.a_ready(cur);
    if constexpr (SP2) {
        PG8_STAGE(PG8_SB(0, 0), cB, voffB); PG8_STAGE(PG8_SB(0, 1), cB + hstepB, voffB); PG8_STAGE(PG8_SA(0, 0), cA, voffA); PG8_STAGE(PG8_SA(0, 1), cA + hstepA, voffA);
        if (wr == 1) PG8_BAR;
        PG8_WAIT_V(2); PG8_BAR;
        PG8_STAGE(PG8_SB(1, 0), cB + kstep, voffB); PG8_STAGE(PG8_SA(1, 0), cA + kstep, voffA); PG8_STAGE(PG8_SB(1, 1), cB + hstepB + kstep, voffB);
        PG8_WAIT_V(6); PG8_BAR;
    } else {
        PG8_STAGE(PG8_SB(0, 0), cB, voffB); PG8_STAGE(PG8_SA(0, 0), cA, voffA); PG8_STAGE(PG8_SB(0, 1), cB + hstepB, voffB); PG8_STAGE(PG8_SA(0, 1), cA + hstepA, voffA);
        if (wr == 1) PG8_BAR;
        PG8_WAIT_V(4); PG8_BAR;
        PG8_STAGE(PG8_SB(1, 0), cB + kstep, voffB); PG8_STAGE(PG8_SA(1, 0), cA + kstep, voffA); PG8_STAGE(PG8_SB(1, 1), cB + hstepB + kstep, voffB);
        PG8_WAIT_V(6); PG8_BAR;
    }
    for (;;) {
        const bool has_next = S.next(ui + 1, nxt);
        const char* nA = has_next ? (const char*)g.A + (size_t)nxt.pm * tstepA : cA; const char* nB = has_next ? (const char*)g.Bt + (size_t)nxt.pn * tstepB : cB;
        for (int t = 0; t < nt; t += 2) {
            const bool last = (t == nt - 2);
            const char* a1 = cA + (size_t)(t + 1) * kstep;
            const char* a2 = last ? nA : cA + (size_t)(t + 2) * kstep; const char* b2 = last ? nB : cB + (size_t)(t + 2) * kstep;
            const char* a3 = a2 + kstep; const char* b3 = b2 + kstep;
            if (last && has_next) S.a_ready(nxt);
            if constexpr (SP2) {
            PG8_LDB(B0, 0, 0); PG8_LDB(B1, 0, 1); PG8_SCHED; PG8_LDA(At, 0, 0); PG8_STAGE(PG8_SA(1, 1), a1 + hstepA, voffA);
            PG8_WAIT_V(8); PG8_WAIT_L(0); PG8_BAR; PG8_MMA(0, 0, At, B0); PG8_MMA(0, 1, At, B1); PG8_BAR; PG8_SCHED;
            PG8_LDA(At, 0, 1); PG8_STAGE(PG8_SB(0, 0), b2, voffB); PG8_STAGE(PG8_SB(0, 1), b2 + hstepB, voffB); PG8_STAGE(PG8_SA(0, 0), a2, voffA);
            PG8_WAIT_V(8); PG8_WAIT_L(0); PG8_BAR; PG8_MMA(1, 0, At, B0); PG8_MMA(1, 1, At, B1); PG8_BAR; PG8_SCHED;
            PG8_LDB(B0, 1, 0); PG8_LDB(B1, 1, 1); PG8_SCHED; PG8_LDA(At, 1, 0); PG8_STAGE(PG8_SA(0, 1), a2 + hstepA, voffA);
            PG8_WAIT_V(8); PG8_WAIT_L(0); PG8_BAR; PG8_MMA(0, 0, At, B0); PG8_MMA(0, 1, At, B1); PG8_BAR; PG8_SCHED;
            PG8_LDA(At, 1, 1); PG8_STAGE(PG8_SB(1, 0), b3, voffB); PG8_STAGE(PG8_SB(1, 1), b3 + hstepB, voffB); PG8_STAGE(PG8_SA(1, 0), a3, voffA);
            PG8_WAIT_V(8); PG8_WAIT_L(0); PG8_BAR; PG8_MMA(1, 0, At, B0); PG8_MMA(1, 1, At, B1); PG8_BAR; PG8_SCHED;
            } else {
            PG8_LDB(B0, 0, 0); PG8_SCHED; PG8_LDA(At, 0, 0); PG8_STAGE(PG8_SA(1, 1), a1 + hstepA, voffA);
            PG8_WAIT_L(8); PG8_BAR; PG8_WAIT_L(0); PG8_MMA(0, 0, At, B0); PG8_BAR; PG8_SCHED;
            PG8_LDB(B1, 0, 1); PG8_STAGE(PG8_SB(0, 0), b2, voffB);
            PG8_BAR; PG8_WAIT_L(0); PG8_MMA(0, 1, At, B1); PG8_BAR;
            PG8_LDA(At, 0, 1); PG8_STAGE(PG8_SA(0, 0), a2, voffA);
            PG8_BAR; PG8_WAIT_L(0); PG8_MMA(1, 0, At, B0); PG8_BAR; PG8_SCHED;
            PG8_STAGE(PG8_SB(0, 1), b2 + hstepB, voffB);
            PG8_WAIT_V(6); PG8_BAR; PG8_MMA(1, 1, At, B1); PG8_BAR;
            PG8_LDB(B0, 1, 0); PG8_SCHED; PG8_LDA(At, 1, 0); PG8_STAGE(PG8_SA(0, 1), a2 + hstepA, voffA);
            PG8_WAIT_L(8); PG8_BAR; PG8_WAIT_L(0); PG8_MMA(0, 0, At, B0); PG8_BAR; PG8_SCHED;
            PG8_LDB(B1, 1, 1); PG8_STAGE(PG8_SB(1, 0), b3, voffB);
            PG8_BAR; PG8_WAIT_L(0); PG8_MMA(0, 1, At, B1); PG8_BAR;
            PG8_LDA(At, 1, 1); PG8_STAGE(PG8_SA(1, 0), a3, voffA);
            PG8_BAR; PG8_WAIT_L(0); PG8_MMA(1, 0, At, B0); PG8_BAR; PG8_SCHED;
            PG8_STAGE(PG8_SB(1, 1), b3 + hstepB, voffB);
            PG8_WAIT_V(6); PG8_BAR; PG8_MMA(1, 1, At, B1); PG8_BAR;
            }
        }
        if constexpr (ALIGN_EPI) { if (wr == 0) PG8_BAR; }
        if constexpr (!Epi::AFTER_DRAIN) { E(acc, cur, wr, wc, fr, fq); S.done(cur); }
        if (!has_next) break;
#pragma unroll
        for (int a = 0; a < 2; ++a)
#pragma unroll
            for (int b = 0; b < 2; ++b)
#pragma unroll
                for (int m = 0; m < 4; ++m)
#pragma unroll
                    for (int n = 0; n < 2; ++n) acc[a][b][m][n] = (f32x4){0.f, 0.f, 0.f, 0.f};
        cur = nxt; cA = nA; cB = nB; ++ui;
        if constexpr (ALIGN_EPI) { if (wr == 1) PG8_BAR; }
    }
    PG8_WAIT_V(0);
    if constexpr (!ALIGN_EPI) { if (wr == 0) PG8_BAR; }
    PG8_BAR;
    if constexpr (Epi::AFTER_DRAIN) { E.fused(acc, cur, wr, wc, fr, fq, lds, wid, lane); S.done(cur); }
#undef PG8_SA
#undef PG8_SB
#undef PG8_STAGE
#undef PG8_LDA
#undef PG8_LDB
#undef PG8_MMA
#undef PG8_WAIT_V
#undef PG8_WAIT_L
#undef PG8_BAR
#undef PG8_SCHED
}
}


typedef unsigned short bf16_t;
typedef short bf16x8 __attribute__((ext_vector_type(8)));
typedef float f32x4 __attribute__((ext_vector_type(4)));
typedef unsigned u32x4 __attribute__((ext_vector_type(4)));
typedef unsigned u32x2 __attribute__((ext_vector_type(2)));
#define LAS __attribute__((address_space(3)))

constexpr int NB = 8, S = 4096, T = NB * S, D = 1024, FF = 2816, DEPTH = 2;
constexpr int HBAT = 4, TH = HBAT * S;
constexpr int NIN = 9216, NPROJ = 6144;
constexpr size_t MiB = 1u << 20;
constexpr size_t E = (size_t)S * 64;
constexpr int NTHREADS = 512, NWAVES = 8;
constexpr int LDS_BYTES = 132 * 1024;
constexpr int LDS_MISC = 131072;

constexpr size_t WS_CTL = 0;
constexpr size_t WS_CS = 1 * MiB;
constexpr size_t WS_W13 = 3 * MiB;
constexpr size_t WS_W2 = 14 * MiB;
constexpr size_t WS_WIN = 20 * MiB;
constexpr size_t WS_WUP = 39 * MiB;
constexpr size_t WS_WOUT = 42 * MiB;
constexpr size_t WS_CW1 = 44 * MiB;
constexpr size_t WS_CW2 = 45 * MiB;
constexpr size_t WS_KC = 46 * MiB;
constexpr size_t WS_U = 48 * MiB;
constexpr size_t WS_R = 112 * MiB;
constexpr size_t MB_QA = 0, MB_KA = 36 * MiB, MB_VA = 72 * MiB;
constexpr size_t MB_QB = 108 * MiB, MB_QBR = 124 * MiB;
constexpr size_t MB_KV = 140 * MiB;
constexpr size_t MB_GB = 164 * MiB;
constexpr size_t MB_QC = 166 * MiB, MB_KC = 178 * MiB, MB_VC = 190 * MiB;
constexpr size_t MB_G = 202 * MiB;
constexpr size_t MB_O = 298 * MiB;
constexpr size_t MB_Y = MB_QA;
constexpr size_t MB_VRM = 338 * MiB;
constexpr size_t WS_NEED = WS_R + 394 * MiB;

__constant__ float ROPE_INV[8] = {1.0f, 0.1939227432012558f, 0.03760603070259094f, 0.007292664609849453f,
                                  0.0014142135623842478f, 0.00027424818836152554f, 5.318296098266728e-05f, 1.0313386155758053e-05f};

typedef float f32x2_t __attribute__((ext_vector_type(2)));
typedef __bf16 bf16x2_t __attribute__((ext_vector_type(2)));
__device__ __forceinline__ unsigned pk_bf16(float lo, float hi) { f32x2_t v = {lo, hi}; bf16x2_t b = __builtin_convertvector(v, bf16x2_t); return __builtin_bit_cast(unsigned, b); }
__device__ __forceinline__ float bflo(unsigned w) { return __builtin_bit_cast(float, w << 16); }
__device__ __forceinline__ float bfhi(unsigned w) { return __builtin_bit_cast(float, w & 0xffff0000u); }
__device__ __forceinline__ float fexp2(float x) { return __builtin_amdgcn_exp2f(x); }
__device__ __forceinline__ float flog2(float x) { return __builtin_amdgcn_logf(x); }
__device__ __forceinline__ float frcp(float x) { return __builtin_amdgcn_rcpf(x); }
__device__ __forceinline__ bf16x8 pack8(f32x4 a, f32x4 b) {
    u32x4 w; w.x = pk_bf16(a[0], a[1]); w.y = pk_bf16(a[2], a[3]); w.z = pk_bf16(b[0], b[1]); w.w = pk_bf16(b[2], b[3]);
    return __builtin_bit_cast(bf16x8, w);
}
__device__ __forceinline__ bf16x8 ld16(const bf16_t* p) { return *(const bf16x8*)p; }
__device__ __forceinline__ f32x4 mfma16(bf16x8 a, bf16x8 b, f32x4 c) { return __builtin_amdgcn_mfma_f32_16x16x32_bf16(a, b, c, 0, 0, 0); }
__device__ __forceinline__ int perm32pos(int p) { return (p & ~31) | ((((p & 15) >> 2) << 3) + (((p >> 4) & 1) << 2) + (p & 3)); }
__device__ __forceinline__ float shx(float v, int mask, int lane) { return __builtin_bit_cast(float, __builtin_amdgcn_ds_bpermute((lane ^ mask) << 2, __builtin_bit_cast(int, v))); }
__device__ __forceinline__ float shi(float v, int src) { return __builtin_bit_cast(float, __builtin_amdgcn_ds_bpermute(src << 2, __builtin_bit_cast(int, v))); }
__device__ __forceinline__ float qx1(float v) { return __builtin_bit_cast(float, __builtin_amdgcn_update_dpp(0, __builtin_bit_cast(int, v), 0xB1, 0xF, 0xF, true)); }
__device__ __forceinline__ float qx2(float v) { return __builtin_bit_cast(float, __builtin_amdgcn_update_dpp(0, __builtin_bit_cast(int, v), 0x4E, 0xF, 0xF, true)); }
constexpr float LOG2E = 1.4426950408889634f, LN2 = 0.6931471805599453f;

struct EpiFfnUp {
    static constexpr bool PERM = true, AFTER_DRAIN = false;
    bf16_t* O;
    __device__ __forceinline__ void operator()(const f32x4 (&acc)[2][2][4][2], const pg8::Unit& u, int wr, int wc, int fr_in, int fq_in) const {
        int lane_e; asm volatile("v_mbcnt_lo_u32_b32 %0, -1, 0\n\tv_mbcnt_hi_u32_b32 %0, -1, %0" : "=v"(lane_e)); const int fr = lane_e & 15, fq = lane_e >> 4; (void)fr_in; (void)fq_in;
        const int row0 = u.pm * 256 + wr * 64 + fr, col0 = u.pn * 128 + wc * 32 + 8 * fq;
        bf16_t* rowp = O + (size_t)row0 * FF + col0;
#pragma unroll
        for (int ai = 0; ai < 2; ++ai) {
#pragma unroll
            for (int m = 0; m < 4; ++m) {
                float r[8];
#pragma unroll
                for (int e = 0; e < 8; ++e) { const float a = acc[ai][0][m][e >> 2][e & 3], b = acc[ai][1][m][e >> 2][e & 3]; r[e] = a * frcp(1.f + fexp2(-a * LOG2E)) * b; }
                u32x4 w; w.x = pk_bf16(r[0], r[1]); w.y = pk_bf16(r[2], r[3]); w.z = pk_bf16(r[4], r[5]); w.w = pk_bf16(r[6], r[7]);
                __builtin_nontemporal_store(w, (u32x4*)rowp);
                rowp += (size_t)16 * FF; asm volatile("" : "+v"(rowp)); }
            rowp += (size_t)64 * FF; asm volatile("" : "+v"(rowp)); }
    }
};
struct EpiResid {
    static constexpr bool PERM = true, AFTER_DRAIN = false;
    const float* src; float* dst; float scale;
    __device__ __forceinline__ void operator()(const f32x4 (&acc)[2][2][4][2], const pg8::Unit& u, int wr, int wc, int fr_in, int fq_in) const {
        int lane_e; asm volatile("v_mbcnt_lo_u32_b32 %0, -1, 0\n\tv_mbcnt_hi_u32_b32 %0, -1, %0" : "=v"(lane_e)); const int fr = lane_e & 15, fq = lane_e >> 4; (void)fr_in; (void)fq_in;
        const int row0 = u.pm * 256 + wr * 64 + fr, col0 = u.pn * 256 + wc * 32 + 8 * fq;
        const float* sp = src + (size_t)row0 * D + col0; float* dp = dst + (size_t)row0 * D + col0;
#pragma unroll
        for (int ai = 0; ai < 2; ++ai) {
            f32x4 sv[4][2][2];
#pragma unroll
            for (int m = 0; m < 4; ++m)
#pragma unroll
                for (int bj = 0; bj < 2; ++bj) { sv[m][bj][0] = *(const f32x4*)(sp + m * 16 * D + bj * 128); sv[m][bj][1] = *(const f32x4*)(sp + m * 16 * D + bj * 128 + 4); }
#pragma unroll
            for (int m = 0; m < 4; ++m)
#pragma unroll
                for (int bj = 0; bj < 2; ++bj) { *(f32x4*)(dp + m * 16 * D + bj * 128) = sv[m][bj][0] + acc[ai][bj][m][0] * scale; *(f32x4*)(dp + m * 16 * D + bj * 128 + 4) = sv[m][bj][1] + acc[ai][bj][m][1] * scale; }
            sp += 128 * D; dp += 128 * D; asm volatile("" : "+v"(sp), "+v"(dp)); }
    }
};
template <bool FIRST> struct EpiUpMerge {
    static constexpr bool PERM = true, AFTER_DRAIN = false;
    const bf16_t* G; bf16_t* Y;
    __device__ __forceinline__ void operator()(const f32x4 (&acc)[2][2][4][2], const pg8::Unit& u, int wr, int wc, int fr_in, int fq_in) const {
        int lane_e; asm volatile("v_mbcnt_lo_u32_b32 %0, -1, 0\n\tv_mbcnt_hi_u32_b32 %0, -1, %0" : "=v"(lane_e)); const int fr = lane_e & 15, fq = lane_e >> 4; (void)fr_in; (void)fq_in;
        const int row0 = u.pm * 256 + wr * 64 + fr, col0 = u.pn * 256 + wc * 32 + 8 * fq;
        const bf16_t* gp = G + (size_t)row0 * 3072 + col0; bf16_t* yp = Y + (size_t)row0 * D + col0;
#pragma unroll
        for (int ai = 0; ai < 2; ++ai) {
            u32x4 gv[4][2], yv[4][2];
#pragma unroll
            for (int m = 0; m < 4; ++m)
#pragma unroll
                for (int bj = 0; bj < 2; ++bj) { gv[m][bj] = *(const u32x4*)(gp + m * 16 * 3072 + bj * 128); if (!FIRST) yv[m][bj] = *(const u32x4*)(yp + m * 16 * D + bj * 128); }
#pragma unroll
            for (int m = 0; m < 4; ++m)
#pragma unroll
                for (int bj = 0; bj < 2; ++bj) {
                    const f32x4 a0 = acc[ai][bj][m][0], a1 = acc[ai][bj][m][1];
                    f32x4 y0 = {0.f, 0.f, 0.f, 0.f}, y1 = {0.f, 0.f, 0.f, 0.f};
                    if (!FIRST) { const u32x4 t = yv[m][bj]; y0 = (f32x4){bflo(t.x), bfhi(t.x), bflo(t.y), bfhi(t.y)}; y1 = (f32x4){bflo(t.z), bfhi(t.z), bflo(t.w), bfhi(t.w)}; }
                    const u32x4 g4 = gv[m][bj];
                    y0 += (f32x4){bflo(g4.x), bfhi(g4.x), bflo(g4.y), bfhi(g4.y)} * a0;
                    y1 += (f32x4){bflo(g4.z), bfhi(g4.z), bflo(g4.w), bfhi(g4.w)} * a1;
                    u32x4 w; w.x = pk_bf16(y0[0], y0[1]); w.y = pk_bf16(y0[2], y0[3]); w.z = pk_bf16(y1[0], y1[1]); w.w = pk_bf16(y1[2], y1[3]);
                    *(u32x4*)(yp + m * 16 * D + bj * 128) = w; }
            gp += 128 * 3072; yp += 128 * D; asm volatile("" : "+v"(gp), "+v"(yp)); }
    }
};
struct EpiInProj {
    static constexpr bool PERM = true, AFTER_DRAIN = false;
    unsigned char* mb; const float* cs;
    __device__ __forceinline__ void operator()(const f32x4 (&acc)[2][2][4][2], const pg8::Unit& u, int wr, int wc, int fr_in, int fq_in) const {
        int lane_e; asm volatile("v_mbcnt_lo_u32_b32 %0, -1, 0\n\tv_mbcnt_hi_u32_b32 %0, -1, %0" : "=v"(lane_e)); const int fr = lane_e & 15, fq = lane_e >> 4; (void)fr_in; (void)fq_in;
        const int row0 = u.pm * 256 + wr * 64 + fr;
#pragma unroll
        for (int bj = 0; bj < 2; ++bj) {
            const int cb = u.pn * 256 + bj * 128 + wc * 32;
            const int hc = cb >> 6;
            if (hc >= 93 && hc < 96) continue;
            const int dd = (cb & 63) + 8 * fq;
            if (hc >= 96) {
                bf16_t* G = (bf16_t*)(mb + MB_G);
#pragma unroll
                for (int ai = 0; ai < 2; ++ai)
#pragma unroll
                    for (int m = 0; m < 4; ++m) { const size_t row = (size_t)(row0 + ai * 128 + m * 16); float v[8];
#pragma unroll
                        for (int e = 0; e < 8; ++e) { const float x = acc[ai][bj][m][e >> 2][e & 3]; v[e] = frcp(1.f + fexp2(-x * LOG2E)); }
                        u32x4 w; w.x = pk_bf16(v[0], v[1]); w.y = pk_bf16(v[2], v[3]); w.z = pk_bf16(v[4], v[5]); w.w = pk_bf16(v[6], v[7]);
                        __builtin_nontemporal_store(w, (u32x4*)(G + row * 3072 + (cb - NPROJ) + 8 * fq)); }
                continue;
            }
            if (hc == 74) {
                float* GBp = (float*)(mb + MB_GB);
                if (dd < 24) {
#pragma unroll
                    for (int ai = 0; ai < 2; ++ai)
#pragma unroll
                        for (int m = 0; m < 4; ++m) { const size_t row = (size_t)(row0 + ai * 128 + m * 16);
#pragma unroll
                            for (int e = 0; e < 8; ++e) { const float x = acc[ai][bj][m][e >> 2][e & 3]; GBp[row * 24 + dd + e] = frcp(1.f + fexp2(-x * LOG2E)); } }
                }
                continue;
            }
            size_t boff; int nh, hd, dl = 0; bool rope = false, tr = false;
            if (hc < 54) { const int g = hc / 18, kd = (hc % 18) / 6; hd = hc % 6; nh = 6; boff = (kd == 0 ? MB_QA : (kd == 1 ? MB_KA : MB_VRM)) + (size_t)g * 12 * MiB; rope = kd < 2; }
            else if (hc < 62) { boff = MB_QB; nh = 8; hd = hc - 54; }
            else if (hc < 74) { const int idx = hc - 62, br = idx >> 2, kvt = (idx >> 1) & 1; hd = idx & 1; nh = 2; boff = (kvt == 1 && br >= 1) ? MB_VRM + (size_t)(32 + 4 * br) * MiB : MB_KV + (size_t)(br * 2 + kvt) * 4 * MiB; rope = (kvt == 0 && br >= 1); }
            else { const int idx = hc - 75, kd = idx / 6; hd = idx % 6; nh = 6; boff = kd == 0 ? MB_QC : (kd == 1 ? MB_KC : MB_VRM + 44 * MiB); }
            bf16_t* base = (bf16_t*)(mb + boff);
            const bool dorope = rope && ((cb & 63) == 0);
#pragma unroll
            for (int ai = 0; ai < 2; ++ai) {
                f32x4 cv[4][4];
                if (dorope) {
#pragma unroll
                    for (int m = 0; m < 4; ++m) { const f32x4* c = (const f32x4*)(cs + (size_t)(row0 + ai * 128 + m * 16) * 16); cv[m][0] = c[0]; cv[m][1] = c[1]; cv[m][2] = c[2]; cv[m][3] = c[3]; }
                }
#pragma unroll
                for (int m = 0; m < 4; ++m) {
                    const int row = row0 + ai * 128 + m * 16; const int hb = row >> 12, t = row & (S - 1);
                    float v[8];
#pragma unroll
                    for (int e = 0; e < 8; ++e) v[e] = acc[ai][bj][m][e >> 2][e & 3];
                    if (dorope) {
#pragma unroll
                        for (int e = 0; e < 8; ++e) { const float other = shx(v[e], 16, fr + 16 * fq);
                            if (fq < 2) { const float co = cv[m][e >> 2][e & 3], si = cv[m][2 + (e >> 2)][e & 3]; v[e] = (fq == 0) ? (v[e] * co - other * si) : (v[e] * co + other * si); } }
                    }
                    u32x4 w; w.x = pk_bf16(v[0], v[1]); w.y = pk_bf16(v[2], v[3]); w.z = pk_bf16(v[4], v[5]); w.w = pk_bf16(v[6], v[7]);
                    __builtin_nontemporal_store(w, (u32x4*)(base + ((size_t)(hb * nh + hd) * S + t) * 64 + dd));
                }
            }
        }
    }
};
__device__ __forceinline__ int in_orig_col(int n) {
    const int hc = n >> 6, d = n & 63;
    if (hc < 54) { const int g = hc / 18, kd = (hc % 18) / 6, slot = hc % 6; return ((kd * 3 + g) * 6 + slot) * 64 + d; }
    if (hc < 62) return 3456 + (hc - 54) * 64 + d;
    if (hc < 74) return 3968 + (hc - 62) * 64 + d;
    if (hc == 74) return d < 24 ? 4736 + d : -1;
    if (hc < 93) return 4760 + (hc - 75) * 64 + d;
    return -1;
}

template <class Epi> __device__ __forceinline__ void run_gemm(LAS unsigned char* lds, const bf16_t* A, int lda, const bf16_t* Bt, int M, int N, int K, const Epi& Ep, int wid_in) {
    int bid = blockIdx.x; asm volatile("" : "+s"(A), "+s"(Bt), "+s"(bid));
    pg8::Gemm g{A, Bt, M, N, K, lda}; pg8::StaticOrder So; So.init(M, N, (int)gridDim.x, bid);
    pg8::gemm_phase<Epi, pg8::StaticOrder, true, true>(lds, g, So, Ep, wid_in);
}

struct AState { f32x4 o[4]; float m, l; };
__device__ __forceinline__ void st_init(AState& a) {
#pragma unroll
    for (int i = 0; i < 4; ++i) a.o[i] = (f32x4){0.f, 0.f, 0.f, 0.f};
    a.m = -1e30f; a.l = 0.f;
}
struct KV { bf16x8 k[4][2]; bf16x8 v[4][2]; };
__device__ __forceinline__ void load_kv(KV& t, const bf16_t* k0, size_t kstride, const bf16_t* vb, size_t vpitch, int g) {
#pragma unroll
    for (int kt = 0; kt < 4; ++kt) { const bf16_t* kr = k0 + kt * kstride; t.k[kt][0] = ld16(kr + 8 * g); t.k[kt][1] = ld16(kr + 32 + 8 * g); }
#pragma unroll
    for (int dt = 0; dt < 4; ++dt)
#pragma unroll
        for (int c = 0; c < 2; ++c) t.v[dt][c] = ld16(vb + (size_t)(16 * dt) * vpitch + c * 32);
}
__device__ __forceinline__ void qk_compute(f32x4 (&s)[4], const KV& t, const bf16x8 (&qf)[2]) {
#pragma unroll
    for (int kt = 0; kt < 4; ++kt) { s[kt] = mfma16(t.k[kt][0], qf[0], (f32x4){0.f, 0.f, 0.f, 0.f}); s[kt] = mfma16(t.k[kt][1], qf[1], s[kt]); }
}
__device__ __forceinline__ void softmax_pv(AState& a, f32x4 (&s)[4], unsigned vm, const bf16x8 (&vf)[4][2], int lane) {
    const float C2 = 0.125f * LOG2E;
    float mx = -1e30f;
#pragma unroll
    for (int kt = 0; kt < 4; ++kt)
#pragma unroll
        for (int j = 0; j < 4; ++j) { const float v = ((vm >> (kt * 4 + j)) & 1u) ? s[kt][j] * C2 : -1e30f; s[kt][j] = v; mx = fmaxf(mx, v); }
    mx = fmaxf(mx, shx(mx, 16, lane)); mx = fmaxf(mx, shx(mx, 32, lane));
    const float mn = fmaxf(a.m, mx);
    const float alpha = fexp2(a.m - mn);
    a.m = mn;
    float ps = 0.f;
#pragma unroll
    for (int kt = 0; kt < 4; ++kt)
#pragma unroll
        for (int j = 0; j < 4; ++j) { const float p = ((vm >> (kt * 4 + j)) & 1u) ? fexp2(s[kt][j] - mn) : 0.f; s[kt][j] = p; ps += p; }
    a.l = a.l * alpha + ps;
    const bf16x8 p0 = pack8(s[0], s[1]), p1 = pack8(s[2], s[3]);
#pragma unroll
    for (int dt = 0; dt < 4; ++dt) { a.o[dt] = a.o[dt] * alpha; a.o[dt] = mfma16(vf[dt][0], p0, a.o[dt]); a.o[dt] = mfma16(vf[dt][1], p1, a.o[dt]); }
}
__device__ __forceinline__ void softmax_pv_nomask(AState& a, f32x4 (&s)[4], float bias, const bf16x8 (&vf)[4][2], int lane) {
    const float C2 = 0.125f * LOG2E;
    float mx = -1e30f;
#pragma unroll
    for (int kt = 0; kt < 4; ++kt)
#pragma unroll
        for (int j = 0; j < 4; ++j) { const float v = fmaf(s[kt][j], C2, bias); s[kt][j] = v; mx = fmaxf(mx, v); }
    mx = fmaxf(mx, shx(mx, 16, lane)); mx = fmaxf(mx, shx(mx, 32, lane));
    const float mn = fmaxf(a.m, mx);
    const float alpha = fexp2(a.m - mn);
    a.m = mn;
    float ps = 0.f;
#pragma unroll
    for (int kt = 0; kt < 4; ++kt)
#pragma unroll
        for (int j = 0; j < 4; ++j) { const float p = fexp2(s[kt][j] - mn); s[kt][j] = p; ps += p; }
    a.l = a.l * alpha + ps;
    const bf16x8 p0 = pack8(s[0], s[1]), p1 = pack8(s[2], s[3]);
#pragma unroll
    for (int dt = 0; dt < 4; ++dt) { a.o[dt] = a.o[dt] * alpha; a.o[dt] = mfma16(vf[dt][0], p0, a.o[dt]); a.o[dt] = mfma16(vf[dt][1], p1, a.o[dt]); }
}
__device__ __forceinline__ float st_inv_l(const AState& a, int lane) {
    float l = a.l; l += shx(l, 16, lane); l += shx(l, 32, lane);
    return l > 0.f ? 1.f / l : 0.f;
}
__device__ __forceinline__ void store_o(bf16_t* dst  , const f32x4 (&o)[4], int g) {
#pragma unroll
    for (int dt = 0; dt < 4; ++dt) { u32x2 w; w.x = pk_bf16(o[dt][0], o[dt][1]); w.y = pk_bf16(o[dt][2], o[dt][3]); *(u32x2*)(dst + 16 * dt + 4 * g) = w; }
}

struct Stg { bf16x8 k, v; };
__device__ __forceinline__ void stg_load(Stg& r, const bf16_t* K, const bf16_t* Vt, int kb, int tid) {
    const int row = tid >> 3, ch = tid & 7;
    r.k = ld16(K + (size_t)(64 * kb + row) * 64 + 8 * ch); r.v = ld16(Vt + (size_t)row * S + 64 * kb + 8 * ch);
}
__device__ __forceinline__ void stg_store(const Stg& r, LAS bf16_t* buf, int tid) {
    const int off = (tid >> 3) * 72 + 8 * (tid & 7);
    *(LAS bf16x8*)(buf + off) = r.k; *(LAS bf16x8*)(buf + 4608 + off) = r.v;
}
__device__ __forceinline__ void lds_frags(KV& t, const LAS bf16_t* buf, int li, int g) {
#pragma unroll
    for (int kt = 0; kt < 4; ++kt) { t.k[kt][0] = *(const LAS bf16x8*)(buf + (16 * kt + li) * 72 + 8 * g); t.k[kt][1] = *(const LAS bf16x8*)(buf + (16 * kt + li) * 72 + 32 + 8 * g); }
#pragma unroll
    for (int dt = 0; dt < 4; ++dt)
#pragma unroll
        for (int c = 0; c < 2; ++c) t.v[dt][c] = *(const LAS bf16x8*)(buf + 4608 + (16 * dt + li) * 72 + c * 32 + 8 * g);
}

__device__ __forceinline__ void attn_A_wave(const unsigned char* mb, int hb, int slot, int tblk, int r, int lane, int w, LAS unsigned char* ldsb) {
    const int g = lane >> 4, li = lane & 15;
    const int tq = 256 * tblk + r + 16 * li;
    AState st; st_init(st);
#pragma unroll
    for (int gi = 0; gi < 3; ++gi) {
        const int dl = 2 * gi, L = S >> dl;
        const int rho = r & ((1 << dl) - 1);
        const int mq = tq >> dl;
        const size_t hoff = (size_t)(hb * 6 + slot) * E;
        const bf16_t* Q = (const bf16_t*)(mb + MB_QA + (size_t)gi * 12 * MiB) + hoff;
        const bf16_t* K = (const bf16_t*)(mb + MB_KA + (size_t)gi * 12 * MiB) + hoff;
        const bf16_t* Vt = (const bf16_t*)(mb + MB_VA + (size_t)gi * 12 * MiB) + hoff;
        bf16x8 qf[2]; qf[0] = ld16(Q + (size_t)tq * 64 + 8 * g); qf[1] = ld16(Q + (size_t)tq * 64 + 32 + 8 * g);
        const int mq_min = (256 * tblk + r) >> dl, mq_max = (256 * tblk + r + 240) >> dl;
        const int tlo = (mq_min > 128 ? mq_min - 128 : 0) >> 6, thi = mq_max >> 6;
        if (gi == 0) {
            const int tid = w * 64 + lane;
            LAS bf16_t* tb0 = (LAS bf16_t*)(ldsb + 16384); LAS bf16_t* tb1 = tb0 + 9216;
            const int tlo0 = 4 * tblk - 2 > 0 ? 4 * tblk - 2 : 0, thi0 = 4 * tblk + 3;
            int cur = 0;
            { Stg r_; stg_load(r_, K, Vt, tlo0, tid); stg_store(r_, tb0, tid); }
            __syncthreads();
            for (int kb = tlo0; kb <= thi0; ++kb) {
                const bool hn = kb < thi0; Stg rn;
                if (hn) stg_load(rn, K, Vt, kb + 1, tid);
                { KV t; lds_frags(t, cur ? tb1 : tb0, li, g);
                  f32x4 s[4]; qk_compute(s, t, qf); unsigned vm = 0;
#pragma unroll
                  for (int kt = 0; kt < 4; ++kt)
#pragma unroll
                      for (int j = 0; j < 4; ++j) { const int dist = mq - (64 * kb + 16 * kt + 4 * g + j); if (dist >= 0 && dist <= 128) vm |= 1u << (kt * 4 + j); }
                  softmax_pv(st, s, vm, t.v, lane); }
                if (hn) stg_store(rn, cur ? tb0 : tb1, tid);
                __syncthreads();
                cur ^= 1;
            }
        } else {
        const bf16_t* kbase = K + (size_t)(rho + (li << dl)) * 64; const size_t ktile = (size_t)64 << (6 + dl), ksub = (size_t)16 << (6 + dl);
        const bf16_t* vbase = Vt + (size_t)li * S + rho * L + 8 * g;
#define A_LOAD(T, tl) load_kv(T, kbase + (size_t)(tl) * ktile, ksub, vbase + 64 * (tl), S, g)
#define A_STEP(T, tl) do { f32x4 s[4]; qk_compute(s, T, qf); unsigned vm = 0; _Pragma("unroll") for (int kt = 0; kt < 4; ++kt) _Pragma("unroll") for (int j = 0; j < 4; ++j) { \
            const int dist = mq - (64 * (tl) + 16 * kt + 4 * g + j); if (dist >= 0 && dist <= 128) vm |= 1u << (kt * 4 + j); } softmax_pv(st, s, vm, T.v, lane); } while (0)
        KV ta, tb;
        A_LOAD(ta, tlo);
        for (int tile = tlo; tile <= thi; tile += 2) {
            A_LOAD(tb, tile + 1 <= thi ? tile + 1 : thi);
            A_STEP(ta, tile);
            if (tile + 1 > thi) break;
            A_LOAD(ta, tile + 2 <= thi ? tile + 2 : thi);
            A_STEP(tb, tile + 1);
        }
#undef A_LOAD
#undef A_STEP
        }
    }
    const float inv = st_inv_l(st, lane);
#pragma unroll
    for (int dt = 0; dt < 4; ++dt) st.o[dt] = st.o[dt] * inv;
    store_o((bf16_t*)(mb + MB_O) + ((size_t)hb * S + tq) * 1280 + slot * 64, st.o, g);
}

__device__ __forceinline__ void attn_C_wave(const unsigned char* mb, int hb, int head, int qb, int w, int lane) {
    const int g = lane >> 4, li = lane & 15;
    const int tq = 128 * qb + 16 * w + li;
    const size_t hoff = (size_t)(hb * 6 + head) * E;
    const bf16_t* Q = (const bf16_t*)(mb + MB_QC) + hoff;
    const bf16_t* K = (const bf16_t*)(mb + MB_KC) + hoff;
    const bf16_t* Vt = (const bf16_t*)(mb + MB_VC) + hoff;
    bf16x8 qf[2]; qf[0] = ld16(Q + (size_t)tq * 64 + 8 * g); qf[1] = ld16(Q + (size_t)tq * 64 + 32 + 8 * g);
    f32x4 o[4];
#pragma unroll
    for (int i = 0; i < 4; ++i) o[i] = (f32x4){0.f, 0.f, 0.f, 0.f};
    float R = 0.f;
    const int thi = (128 * qb + 16 * w + 14) >> 6;
    const bf16_t* kbase = K + (size_t)li * 64; const bf16_t* vbase = Vt + (size_t)li * S + 8 * g;
#define C_LOAD(T, tl) load_kv(T, kbase + (size_t)(tl) * 4096, 1024, vbase + 64 * (tl), S, g)
#define C_STEP(T, tl) do { f32x4 s[4]; qk_compute(s, T, qf); f32x4 Lm[4], Lp[4]; float tot[4], sgt[4]; \
        _Pragma("unroll") for (int kt = 0; kt < 4; ++kt) { float gs = 0.f; \
            _Pragma("unroll") for (int j = 0; j < 4; ++j) { const int key = 64 * (tl) + 16 * kt + 4 * g + j; const bool valid = key < tq; \
                const float z = s[kt][j] * 0.125f; const float e = fexp2(-fabsf(z) * LOG2E); const float sp = fmaxf(z, 0.f) + flog2(1.f + e) * LN2; \
                Lm[kt][j] = valid ? -sp : 0.f; Lp[kt][j] = valid ? (z - sp) : -1e30f; gs += Lm[kt][j]; } \
            const float x1 = shx(gs, 16, lane), x2 = shx(gs, 32, lane), x3 = shx(gs, 48, lane); \
            tot[kt] = gs + x1 + x2 + x3; \
            sgt[kt] = (((g ^ 1) > g) ? x1 : 0.f) + (((g ^ 2) > g) ? x2 : 0.f) + (((g ^ 3) > g) ? x3 : 0.f); } \
        float off[4]; off[3] = R + sgt[3]; off[2] = R + tot[3] + sgt[2]; off[1] = R + tot[3] + tot[2] + sgt[1]; off[0] = R + tot[3] + tot[2] + tot[1] + sgt[0]; \
        R += tot[0] + tot[1] + tot[2] + tot[3]; \
        _Pragma("unroll") for (int kt = 0; kt < 4; ++kt) { float run = off[kt]; \
            _Pragma("unroll") for (int j = 3; j >= 0; --j) { const float a = fexp2((Lp[kt][j] + run) * LOG2E); run += Lm[kt][j]; s[kt][j] = a; } } \
        const bf16x8 p0 = pack8(s[0], s[1]), p1 = pack8(s[2], s[3]); \
        _Pragma("unroll") for (int dt = 0; dt < 4; ++dt) { o[dt] = mfma16(T.v[dt][0], p0, o[dt]); o[dt] = mfma16(T.v[dt][1], p1, o[dt]); } } while (0)
#define C_DONE() (__builtin_amdgcn_ballot_w64(R > -110.f) == 0ull)
    KV ta, tb;
    C_LOAD(ta, thi);
    for (int tile = thi; tile >= 0; tile -= 2) {
        C_LOAD(tb, tile >= 1 ? tile - 1 : 0);
        C_STEP(ta, tile);
        if (tile < 1 || C_DONE()) break;
        C_LOAD(ta, tile >= 2 ? tile - 2 : 0);
        C_STEP(tb, tile - 1);
        if (C_DONE()) break;
    }
#undef C_LOAD
#undef C_STEP
#undef C_DONE
    store_o((bf16_t*)(mb + MB_O) + ((size_t)hb * S + tq) * 1280 + 896 + head * 64, o, g);
}


__device__ __forceinline__ void attn_B_unit(const unsigned char* mb, const unsigned char* ws, int hb, int gk, int qt, int w, int lane, LAS float* sc, LAS unsigned char* ldsb, const float* cs) {
    const int g = lane >> 4, li = lane & 15, qi = li >> 2, hh = li & 3;
    const int ql = 4 * w + qi, tq = 32 * qt + ql, h = gk * 4 + hh;
    const int tmin = 32 * qt + 4 * w, tmax = tmin + 3;
    const size_t tau = (size_t)hb * S + tq;
    const float* gb = (const float*)(mb + MB_GB) + tau * 24 + h * 3;
    const float g0 = gb[0], g1 = gb[1], g2 = gb[2];
    f32x4 res[4];
    const int tid = w * 64 + lane;
    const bf16_t* Qp = (const bf16_t*)(mb + MB_QB) + (size_t)(hb * 8 + h) * E + (size_t)tq * 64;
    bf16x8 qraw[2]; qraw[0] = ld16(Qp + 8 * g); qraw[1] = ld16(Qp + 32 + 8 * g);
    f32x4 cv[4]; { const f32x4* c4 = (const f32x4*)(cs + (tau << 4)); cv[0] = c4[0]; cv[1] = c4[1]; cv[2] = c4[2]; cv[3] = c4[3]; }
    Stg r0; stg_load(r0, (const bf16_t*)(mb + MB_KV + 2 * 4 * MiB) + (size_t)(hb * 2 + gk) * E, (const bf16_t*)(mb + MB_KV + 3 * 4 * MiB) + (size_t)(hb * 2 + gk) * E, 0, tid);
    {
        bf16x8 qf[2]; qf[0] = qraw[0]; qf[1] = qraw[1];
        const bf16_t* kc = (const bf16_t*)(ws + WS_KC) + (size_t)(hb * 2 + gk) * 256 * 64;
        const bf16_t* vct = (const bf16_t*)(ws + WS_KC + 512 * 1024) + (size_t)(hb * 2 + gk) * 64 * 256;
        const int cmaxw = tmax >= 31 ? (tmax - 31) >> 4 : -1;
        const int n16 = (cmaxw >> 4) + 1;
        const int cq = tq >= 31 ? (tq - 31) >> 4 : -1;
        f32x4 sa[16];
#pragma unroll
        for (int kt = 0; kt < 16; ++kt) {
            sa[kt] = (f32x4){0.f, 0.f, 0.f, 0.f};
            if (kt < n16) { const bf16_t* kr = kc + (size_t)(16 * kt + li) * 64; sa[kt] = mfma16(ld16(kr + 8 * g), qf[0], sa[kt]); sa[kt] = mfma16(ld16(kr + 32 + 8 * g), qf[1], sa[kt]); }
        }
        const float C2 = 0.125f * LOG2E;
        float mx = -1e30f;
#pragma unroll
        for (int kt = 0; kt < 16; ++kt)
#pragma unroll
            for (int j = 0; j < 4; ++j) if (kt < n16) { const float v = (16 * kt + 4 * g + j <= cq) ? sa[kt][j] * C2 : -1e30f; sa[kt][j] = v; mx = fmaxf(mx, v); }
        mx = fmaxf(mx, shx(mx, 16, lane)); mx = fmaxf(mx, shx(mx, 32, lane));
        float ps = 0.f;
#pragma unroll
        for (int kt = 0; kt < 16; ++kt)
#pragma unroll
            for (int j = 0; j < 4; ++j) if (kt < n16) { const float p = (sa[kt][j] > -1e29f) ? fexp2(sa[kt][j] - mx) : 0.f; sa[kt][j] = p; ps += p; }
        ps += shx(ps, 16, lane); ps += shx(ps, 32, lane);
        const float inv = ps > 0.f ? 1.f / ps : 0.f;
#pragma unroll
        for (int kt = 0; kt < 16; ++kt) if (kt < n16) sa[kt] = sa[kt] * inv;
        f32x4 o[4];
#pragma unroll
        for (int i = 0; i < 4; ++i) o[i] = (f32x4){0.f, 0.f, 0.f, 0.f};
#pragma unroll
        for (int c = 0; c < 8; ++c)
            if (2 * c < n16) { const bf16x8 pf = pack8(sa[2 * c], sa[2 * c + 1]);
#pragma unroll
                for (int dt = 0; dt < 4; ++dt) o[dt] = mfma16(ld16(vct + (size_t)(16 * dt + li) * 256 + c * 32 + 8 * g), pf, o[dt]);
                }
#pragma unroll
        for (int i = 0; i < 4; ++i) res[i] = o[i] * g0;
#pragma unroll
        for (int kt = 0; kt < 16; ++kt)
            if (kt < n16) {
#pragma unroll
                for (int j = 0; j < 4; ++j) { float v = sa[kt][j]; v += qx1(v); v += qx2(v); sa[kt][j] = v; } }
        float nx[17];
#pragma unroll
        for (int kt = 0; kt < 16; ++kt) nx[kt] = shi(sa[kt][0], (lane + 16) & 63);
        nx[16] = 0.f;
#pragma unroll
        for (int kt = 0; kt < 16; ++kt) { const float scv = sa[kt][0] + 2.f * (sa[kt][1] + sa[kt][2] + sa[kt][3]) + (g < 3 ? nx[kt] : nx[kt + 1]);
            if (hh == 0) sc[ql * 64 + 4 * kt + g] = scv; }
    }
    __syncthreads();
    unsigned long long mk0, mk1, mk2, mk3;
    {
        unsigned long long mks[4];
#pragma unroll
        for (int q2 = 0; q2 < 4; ++q2) {
            const int t = 32 * qt + 4 * w + q2, cur = t >> 6, j = lane;
            float v = sc[(4 * w + q2) * 64 + j];
            const bool forced = (j == 0) || (j == cur) || (j == cur - 1);
            v = forced ? 1e4f : ((j <= cur) ? v : -1.f);
            int rank = 0;
            const int jend = (tmax >> 6) + 1;
#pragma unroll 4
            for (int jj = 0; jj < jend; ++jj) { const float ov = __builtin_bit_cast(float, __builtin_amdgcn_readlane(__builtin_bit_cast(int, v), jj)); rank += ((ov > v) || (ov == v && jj < j)) ? 1 : 0; }
            mks[q2] = __ballot(rank < 16);
        }
        mk0 = mks[0]; mk1 = mks[1]; mk2 = mks[2]; mk3 = mks[3];
    }
    LAS unsigned long long* umw = (LAS unsigned long long*)(ldsb + 8192);
    if (lane == 0) umw[w] = mk0 | mk1 | mk2 | mk3;
    __syncthreads();
    int li_l = lane & 15, g_l = lane >> 4; asm volatile("" : "+v"(li_l), "+v"(g_l));
    const unsigned long long selm = qi == 0 ? mk0 : (qi == 1 ? mk1 : (qi == 2 ? mk2 : mk3));
    const unsigned long long um = mk0 | mk1 | mk2 | mk3;
    bf16x8 qf[2];
    {
        qf[1] = qraw[1];
        u32x4 qw = __builtin_bit_cast(u32x4, qraw[0]); float x[8];
        x[0] = bflo(qw.x); x[1] = bfhi(qw.x); x[2] = bflo(qw.y); x[3] = bfhi(qw.y); x[4] = bflo(qw.z); x[5] = bfhi(qw.z); x[6] = bflo(qw.w); x[7] = bfhi(qw.w);
#pragma unroll
        for (int e = 0; e < 8; ++e) { const float other = shx(x[e], 16, lane); const float co = cv[e >> 2][e & 3], si = cv[2 + (e >> 2)][e & 3];
            x[e] = (g_l == 0) ? (x[e] * co - other * si) : ((g_l == 1) ? (x[e] * co + other * si) : x[e]); }
        qw.x = pk_bf16(x[0], x[1]); qw.y = pk_bf16(x[2], x[3]); qw.z = pk_bf16(x[4], x[5]); qw.w = pk_bf16(x[6], x[7]);
        qf[0] = __builtin_bit_cast(bf16x8, qw);
    }
    LAS bf16_t* tb0 = (LAS bf16_t*)(ldsb + 16384); LAS bf16_t* tb1 = tb0 + 9216;
    unsigned long long bum = 0ull;
#pragma unroll
    for (int i = 0; i < 8; ++i) bum |= umw[i];
    const int kbhi_b = (32 * qt + 31) >> 6;
    {
        const bf16_t* K = (const bf16_t*)(mb + MB_KV + 2 * 4 * MiB) + (size_t)(hb * 2 + gk) * E;
        const bf16_t* Vt = (const bf16_t*)(mb + MB_KV + 3 * 4 * MiB) + (size_t)(hb * 2 + gk) * E;
        AState st; st_init(st);
        unsigned long long rem = bum & ((kbhi_b >= 63) ? ~0ull : ((2ull << kbhi_b) - 1ull));
        int kb = 0, cur = 0; bool have = rem != 0ull;
        if (have) { kb = __builtin_ctzll(rem); rem &= rem - 1ull; stg_store(r0, tb0, tid); }
        __syncthreads();
        while (have) {
            const bool hn = rem != 0ull; int kbn = 0; Stg rn;
            if (hn) { kbn = __builtin_ctzll(rem); rem &= rem - 1ull; stg_load(rn, K, Vt, kbn, tid); }
            if ((um >> kb) & 1ull) {
                KV t; lds_frags(t, cur ? tb1 : tb0, li_l, g_l);
                f32x4 s[4]; qk_compute(s, t, qf);
                if (kb > 0 && 64 * kb + 63 <= tmin) {
                    softmax_pv_nomask(st, s, ((selm >> kb) & 1ull) ? 0.f : -1e30f, t.v, lane);
                } else {
                    unsigned vm = 0;
                    if ((selm >> kb) & 1ull) {
#pragma unroll
                        for (int kt = 0; kt < 4; ++kt)
#pragma unroll
                            for (int j = 0; j < 4; ++j) if (64 * kb + 16 * kt + 4 * g_l + j <= tq) vm |= 1u << (kt * 4 + j);
                    }
                    softmax_pv(st, s, vm, t.v, lane);
                }
            }
            if (hn) stg_store(rn, cur ? tb0 : tb1, tid);
            __syncthreads();
            cur ^= 1; kb = kbn; have = hn;
        }
        const float inv = st_inv_l(st, lane) * g1;
#pragma unroll
        for (int i = 0; i < 4; ++i) res[i] += st.o[i] * inv;
    }
    {
        const bf16_t* K = (const bf16_t*)(mb + MB_KV + 4 * 4 * MiB) + (size_t)(hb * 2 + gk) * E;
        const bf16_t* Vt = (const bf16_t*)(mb + MB_KV + 5 * 4 * MiB) + (size_t)(hb * 2 + gk) * E;
        AState st; st_init(st);
        const int kblo = (32 * qt > 511 ? 32 * qt - 511 : 0) >> 6;
        int cur = 0;
        { Stg r; stg_load(r, K, Vt, kblo, tid); stg_store(r, tb0, tid); }
        __syncthreads();
        for (int kb = kblo; kb <= kbhi_b; ++kb) {
            const bool hn = kb < kbhi_b; Stg rn;
            if (hn) stg_load(rn, K, Vt, kb + 1, tid);
            {
                KV t; lds_frags(t, cur ? tb1 : tb0, li_l, g_l);
                f32x4 s[4]; qk_compute(s, t, qf);
                if (64 * kb >= tmax - 511 && 64 * kb + 63 <= tmin) {
                    softmax_pv_nomask(st, s, 0.f, t.v, lane);
                } else {
                    unsigned vm = 0;
#pragma unroll
                    for (int kt = 0; kt < 4; ++kt)
#pragma unroll
                        for (int j = 0; j < 4; ++j) { const int dist = tq - (64 * kb + 16 * kt + 4 * g_l + j); if (dist >= 0 && dist <= 511) vm |= 1u << (kt * 4 + j); }
                    softmax_pv(st, s, vm, t.v, lane);
                }
            }
            if (hn) stg_store(rn, cur ? tb0 : tb1, tid);
            __syncthreads();
            cur ^= 1;
        }
        const float inv = st_inv_l(st, lane) * g2;
#pragma unroll
        for (int i = 0; i < 4; ++i) res[i] += st.o[i] * inv;
    }
    store_o((bf16_t*)(mb + MB_O) + tau * 1280 + 384 + h * 64, res, g);
}

__device__ __forceinline__ void compress_block(const unsigned char* mb, unsigned char* ws, int kv, int hb, int gk, int rb, int w, int lane, LAS bf16_t* hid) {
    const int g = lane >> 4, li = lane & 15;
    const bf16_t* src = (const bf16_t*)(mb + MB_KV + (size_t)kv * 4 * MiB) + (size_t)(hb * 2 + gk) * E;
    const bf16_t* W1t = (const bf16_t*)(ws + WS_CW1) + (size_t)kv * 128 * 2048 + (size_t)(16 * w + li) * 2048 + 8 * g;
    const bf16_t* W2t = (const bf16_t*)(ws + WS_CW2) + (size_t)kv * 64 * 128;
    const float* bias = (const float*)(ws + WS_CW2 + 65536) + kv * 128;
    const int row = 16 * rb + li;
    f32x4 hacc = {0.f, 0.f, 0.f, 0.f};
#pragma unroll 8
    for (int lt = 0; lt < 32; ++lt) {
        int tok = 16 * row + lt; tok = tok < S ? tok : S - 1;
        const bf16_t* xr = src + (size_t)tok * 64 + 8 * g;
        hacc = mfma16(ld16(W1t + lt * 64), ld16(xr), hacc);
        hacc = mfma16(ld16(W1t + lt * 64 + 32), ld16(xr + 32), hacc);
    }
    float hv[4];
#pragma unroll
    for (int j = 0; j < 4; ++j) { const float x = hacc[j] + bias[16 * w + 4 * g + j];
        const float y = 0.7978845608028654f * (x + 0.044715f * x * x * x);
        const float th = 1.f - 2.f * frcp(fexp2(2.f * y * LOG2E) + 1.f);
        hv[j] = 0.5f * x * (1.f + th); }
    { u32x2 wv; wv.x = pk_bf16(hv[0], hv[1]); wv.y = pk_bf16(hv[2], hv[3]); *(LAS u32x2*)(hid + li * 136 + 16 * w + 4 * g) = wv; }
    __syncthreads();
    if (w < 4) {
        const int dt = w;
        f32x4 o = {0.f, 0.f, 0.f, 0.f};
#pragma unroll
        for (int c = 0; c < 4; ++c) {
            const u32x2 plo = *(const LAS u32x2*)(hid + li * 136 + 32 * c + 4 * g), phi = *(const LAS u32x2*)(hid + li * 136 + 32 * c + 16 + 4 * g);
            u32x4 pv; pv.x = plo.x; pv.y = plo.y; pv.z = phi.x; pv.w = phi.y;
            const bf16_t* wr_ = W2t + (size_t)(16 * dt + li) * 128 + 32 * c + 4 * g;
            const u32x2 lo = *(const u32x2*)wr_, hi = *(const u32x2*)(wr_ + 16);
            u32x4 wv; wv.x = lo.x; wv.y = lo.y; wv.z = hi.x; wv.w = hi.y;
            o = mfma16(__builtin_bit_cast(bf16x8, wv), __builtin_bit_cast(bf16x8, pv), o);
        }
        if (kv == 0) { bf16_t* kc = (bf16_t*)(ws + WS_KC) + (size_t)(hb * 2 + gk) * 256 * 64 + (size_t)row * 64 + 16 * dt + 4 * g;
            u32x2 wv; wv.x = pk_bf16(o[0], o[1]); wv.y = pk_bf16(o[2], o[3]); *(u32x2*)kc = wv; }
        else { bf16_t* vct = (bf16_t*)(ws + WS_KC + 512 * 1024) + (size_t)(hb * 2 + gk) * 64 * 256 + perm32pos(row);
#pragma unroll
            for (int j = 0; j < 4; j += 2) { const unsigned wv = pk_bf16(o[j], o[j + 1]); vct[(size_t)(16 * dt + 4 * g + j) * 256] = (bf16_t)(wv & 0xffffu); vct[(size_t)(16 * dt + 4 * g + j + 1) * 256] = (bf16_t)(wv >> 16); } }
    }
    __syncthreads();
}

__device__ __forceinline__ void transpose_wave(const bf16_t* src, bf16_t* dst, int dl, int pb, bf16_t* tile, int lane) {
    const int L = S >> dl, pstart = 64 * pb, rho = pstart >> (12 - dl), mk0 = pstart & (L - 1);
#pragma unroll
    for (int i = 0; i < 8; ++i) { const int key = 8 * i + (lane >> 3); const int tok = rho + ((mk0 + key) << dl);
        *(bf16x8*)(tile + key * 72 + 8 * (lane & 7)) = ld16(src + (size_t)tok * 64 + 8 * (lane & 7)); }
    asm volatile("s_waitcnt vmcnt(0) lgkmcnt(0)" ::: "memory");
#pragma unroll
    for (int i = 0; i < 8; ++i) { const int o = lane + 64 * i, d = o >> 3, grp = o & 7, kb0 = 32 * (grp >> 2) + 4 * (grp & 3);
        unsigned short v[8];
#pragma unroll
        for (int e = 0; e < 8; ++e) v[e] = tile[(kb0 + (e < 4 ? e : 12 + e)) * 72 + d];
        u32x4 w; w.x = v[0] | ((unsigned)v[1] << 16); w.y = v[2] | ((unsigned)v[3] << 16); w.z = v[4] | ((unsigned)v[5] << 16); w.w = v[6] | ((unsigned)v[7] << 16);
        *(u32x4*)(dst + (size_t)d * S + pstart + 8 * grp) = w; }
    asm volatile("s_waitcnt lgkmcnt(0)" ::: "memory");
}

__device__ __forceinline__ float wave_sum(float v, int lane) {
#pragma unroll
    for (int o = 1; o < 64; o <<= 1) v += shx(v, o, lane);
    return v;
}
__device__ __forceinline__ void norm_rows_bf16(const float* src, const float* gain, bf16_t* dst, int gw, int ngw, int lane) {
    f32x4 gv[4];
#pragma unroll
    for (int j = 0; j < 4; ++j) gv[j] = *(const f32x4*)(gain + 4 * lane + 256 * j);
    for (int row0 = gw; row0 < T; row0 += 4 * ngw) {
        f32x4 v[4][4]; float ss[4];
#pragma unroll
        for (int r = 0; r < 4; ++r) { const int row = row0 + r * ngw; const float* xr = src + (size_t)(row < T ? row : row0) * D + 4 * lane; ss[r] = 0.f;
#pragma unroll
            for (int j = 0; j < 4; ++j) { v[r][j] = *(const f32x4*)(xr + 256 * j); ss[r] += (v[r][j][0] * v[r][j][0] + v[r][j][1] * v[r][j][1]) + (v[r][j][2] * v[r][j][2] + v[r][j][3] * v[r][j][3]); } }
#pragma unroll
        for (int o = 1; o < 64; o <<= 1) {
#pragma unroll
            for (int r = 0; r < 4; ++r) ss[r] += shx(ss[r], o, lane); }
#pragma unroll
        for (int r = 0; r < 4; ++r) { const int row = row0 + r * ngw; if (row < T) { const float rstd = 1.f / sqrtf(ss[r] * (1.f / D) + 1e-6f);
            bf16_t* orow = dst + (size_t)row * D + 4 * lane;
#pragma unroll
            for (int j = 0; j < 4; ++j) { const f32x4 y = v[r][j] * rstd * gv[j]; u32x2 w; w.x = pk_bf16(y[0], y[1]); w.y = pk_bf16(y[2], y[3]); *(u32x2*)(orow + 256 * j) = w; } } }
    }
}
__device__ __forceinline__ void norm_rows_f32_inplace(float* buf, const float* gain, int gw, int ngw, int lane) {
    f32x4 gv[4];
#pragma unroll
    for (int j = 0; j < 4; ++j) gv[j] = *(const f32x4*)(gain + 4 * lane + 256 * j);
    for (int row = gw; row < T; row += ngw) {
        float* xr = buf + (size_t)row * D + 4 * lane; f32x4 v[4]; float ss = 0.f;
#pragma unroll
        for (int j = 0; j < 4; ++j) { v[j] = *(const f32x4*)(xr + 256 * j); ss += (v[j][0] * v[j][0] + v[j][1] * v[j][1]) + (v[j][2] * v[j][2] + v[j][3] * v[j][3]); }
        const float rstd = 1.f / sqrtf(wave_sum(ss, lane) * (1.f / D) + 1e-6f);
#pragma unroll
        for (int j = 0; j < 4; ++j) *(f32x4*)(xr + 256 * j) = v[j] * rstd * gv[j];
    }
}
__device__ __forceinline__ void tr_item(const float* base, int nvalid, int ld, int k0, bf16_t* WT, int K, int n0, float* scr, int lane) {
    const int g4 = lane & 7;
#pragma unroll
    for (int i = 0; i < 8; ++i) { const int kk = 8 * i + (lane >> 3);
        f32x4 v = {0.f, 0.f, 0.f, 0.f};
        if (4 * g4 < nvalid) v = *(const f32x4*)(base + (size_t)(k0 + kk) * ld + 4 * g4);
        float* d = scr + kk * 33 + 4 * g4; d[0] = v[0]; d[1] = v[1]; d[2] = v[2]; d[3] = v[3]; }
    asm volatile("s_waitcnt lgkmcnt(0)" ::: "memory");
    const int c = lane & 7;
#pragma unroll
    for (int j = 0; j < 4; ++j) { const int n = (lane >> 3) + 8 * j; const float* s = scr + (8 * c) * 33 + n;
        u32x4 o; o.x = pk_bf16(s[0 * 33], s[1 * 33]); o.y = pk_bf16(s[2 * 33], s[3 * 33]); o.z = pk_bf16(s[4 * 33], s[5 * 33]); o.w = pk_bf16(s[6 * 33], s[7 * 33]);
        *(u32x4*)(WT + (size_t)(n0 + n) * K + k0 + 8 * c) = o; }
    asm volatile("s_waitcnt lgkmcnt(0)" ::: "memory");
}
__device__ __forceinline__ void conv_ffn(const float* w1, const float* w3, const float* w2, unsigned char* ws, float* scr, int gw, int ngw, int lane) {
    constexpr int I13 = 16 * 176, I2 = 44 * 32;
    bf16_t* W13t = (bf16_t*)(ws + WS_W13); bf16_t* W2t = (bf16_t*)(ws + WS_W2);
    for (int it = gw; it < I13 + I2; it += ngw) {
        if (it < I13) { const int kb = it / 176, nb = it % 176, n = 32 * nb, j = 128 * (n >> 8) + (n & 127);
            tr_item(((n & 255) < 128 ? w1 : w3) + j, 32, FF, 64 * kb, W13t, D, 32 * nb, scr, lane); }
        else { const int r = it - I13, kb = r / 32, nb = r % 32; tr_item(w2 + 32 * nb, 32, D, 64 * kb, W2t, FF, 32 * nb, scr, lane); }
    }
}
__device__ __forceinline__ void conv_mixer(const float* w_in, const float* w_gate, const float* w_up, const float* w_out, const float* cw1k, const float* cw2k, const float* cw1v, const float* cw2v,
                                           const float* pek, const float* pev, unsigned char* ws, float* scr, int gw, int ngw, int lane) {
    constexpr int I_IN = 16 * 288, I_UP0 = 6 * 32, I_UP1 = 8 * 32, I_UP2 = 6 * 32, I_OUT = 16 * 32, I_C1 = 32 * 4, I_C2 = 2 * 2, I_B = 8;
    constexpr int NI = I_IN + I_UP0 + I_UP1 + I_UP2 + I_OUT + 2 * I_C1 + 2 * I_C2 + I_B;
    for (int it = gw; it < NI; it += ngw) {
        int r = it;
        if (r < I_IN) { const int kb = r / 288, nb = r % 288, n = 32 * nb; const float* base = w_in; int nvalid = 0;
            if (n >= NPROJ) { base = w_gate + (n - NPROJ); nvalid = 32; }
            else if ((n >> 6) == 74) { if ((n & 63) == 0) { base = w_in + 4736; nvalid = 24; } }
            else { const int oc = in_orig_col(n); if (oc >= 0) { base = w_in + oc; nvalid = 32; } }
            tr_item(base, nvalid, n >= NPROJ ? 3072 : 5912, 64 * kb, (bf16_t*)(ws + WS_WIN), D, 32 * nb, scr, lane); continue; }
        r -= I_IN;
        if (r < I_UP0) { const int kb = r / 32, nb = r % 32; tr_item(w_up + 32 * nb, 32, D, 64 * kb, (bf16_t*)(ws + WS_WUP), 384, 32 * nb, scr, lane); continue; }
        r -= I_UP0;
        if (r < I_UP1) { const int kb = r / 32, nb = r % 32; tr_item(w_up + (size_t)384 * D + 32 * nb, 32, D, 64 * kb, (bf16_t*)(ws + WS_WUP) + 1024 * 384, 512, 32 * nb, scr, lane); continue; }
        r -= I_UP1;
        if (r < I_UP2) { const int kb = r / 32, nb = r % 32; tr_item(w_up + (size_t)896 * D + 32 * nb, 32, D, 64 * kb, (bf16_t*)(ws + WS_WUP) + 1024 * 896, 384, 32 * nb, scr, lane); continue; }
        r -= I_UP2;
        if (r < I_OUT) { const int kb = r / 32, nb = r % 32; tr_item(w_out + 32 * nb, 32, D, 64 * kb, (bf16_t*)(ws + WS_WOUT), D, 32 * nb, scr, lane); continue; }
        r -= I_OUT;
        if (r < 2 * I_C1) { const int kv = r / I_C1, q = r % I_C1, kb = q / 4, nb = q % 4; tr_item((kv ? cw1v : cw1k) + 32 * nb, 32, 128, 64 * kb, (bf16_t*)(ws + WS_CW1) + (size_t)kv * 128 * 2048, 2048, 32 * nb, scr, lane); continue; }
        r -= 2 * I_C1;
        if (r < 2 * I_C2) { const int kv = r / I_C2, q = r % I_C2, kb = q / 2, nb = q % 2; tr_item((kv ? cw2v : cw2k) + 32 * nb, 32, 64, 64 * kb, (bf16_t*)(ws + WS_CW2) + (size_t)kv * 64 * 128, 128, 32 * nb, scr, lane); continue; }
        r -= 2 * I_C2;
        {
            const int kv = r >> 2, n = 32 * (r & 3) + (lane & 31); const float* pe = kv ? pev : pek; const float* w1 = kv ? cw1v : cw1k; float a = 0.f;
            for (int kq = (lane >> 5); kq < 2048; kq += 2) a += pe[kq] * w1[(size_t)kq * 128 + n];
            a += shx(a, 32, lane);
            if (lane < 32) ((float*)(ws + WS_CW2 + 65536))[kv * 128 + n] = a;
        }
    }
}

#ifndef DUP
#define DUP 0
#endif
#ifndef NHF
#define NHF 2
#endif
#ifndef PHM
#define PHM 0xFFFF
#endif
struct Params { const float* in[22]; float* out; unsigned char* ws; };

#define BW_XC(j) (2048 + 64 * (j))
#define BW_XS(j) (2560 + 64 * (j))
#define BW_XG(j) (3072 + 64 * (j))
#define BW_TOP 3584
#define BW_TG 3648
__device__ __forceinline__ unsigned bw_ld(unsigned* p) { return __hip_atomic_load(p, __ATOMIC_RELAXED, __HIP_MEMORY_SCOPE_AGENT); }
__device__ __forceinline__ unsigned bw_add(unsigned* p) { return __hip_atomic_fetch_add(p, 1u, __ATOMIC_RELAXED, __HIP_MEMORY_SCOPE_AGENT); }
__device__ __forceinline__ void grid_bar2(unsigned* ctl, unsigned n, bool leader) {
    asm volatile("s_waitcnt vmcnt(0) lgkmcnt(0)" ::: "memory");
    __syncthreads();
    if (leader) {
        const unsigned x = (unsigned)__builtin_amdgcn_s_getreg((3 << 11) | 20) & 7u;
        const unsigned nloc = bw_ld(ctl + BW_XC(x));
        unsigned nx = 0;
#pragma unroll
        for (int j = 0; j < 8; ++j) nx += bw_ld(ctl + BW_XC(j)) != 0u ? 1u : 0u;
        const unsigned old = bw_add(ctl + BW_XS(x));
        if (old + 1u == n * nloc) {
            __builtin_amdgcn_fence(__ATOMIC_RELEASE, "agent");
            asm volatile("s_waitcnt vmcnt(0)" ::: "memory");
            const unsigned og = bw_add(ctl + BW_TOP);
            if (og + 1u == n * nx) bw_add(ctl + BW_TG);
            else while (bw_ld(ctl + BW_TG) < n) __builtin_amdgcn_s_sleep(2);
            bw_add(ctl + BW_XG(x));
        } else {
            while (bw_ld(ctl + BW_XG(x)) < n) __builtin_amdgcn_s_sleep(2);
        }
        __builtin_amdgcn_fence(__ATOMIC_ACQUIRE, "agent");
        asm volatile("s_waitcnt vmcnt(0)" ::: "memory");
    }
    __syncthreads();
}
__global__ void __launch_bounds__(NTHREADS, 2) hybrid_fwd(Params p) {
    extern __shared__ __attribute__((aligned(16))) unsigned char lds_raw[];
    cg::grid_group grid = cg::this_grid();
    LAS unsigned char* lds = (LAS unsigned char*)lds_raw;
    const int G0 = gridDim.x;
    unsigned nbar = 0;
#define GBAR() do { ++nbar; int l_; asm volatile("v_mbcnt_lo_u32_b32 %0, -1, 0\n\tv_mbcnt_hi_u32_b32 %0, -1, %0" : "=v"(l_)); unsigned char* w_ = p.ws; asm volatile("" : "+s"(w_)); grid_bar2((unsigned*)(w_ + WS_CTL), nbar, wave0 == 0 && l_ == 0); } while (0)
#define GSYNC() GBAR()
    const int wave0 = __builtin_amdgcn_readfirstlane(threadIdx.x >> 6);
#define PH int G = G0; asm volatile("" : "+s"(G)); const int ngw = G * NWAVES; (void)ngw; int lane_; asm volatile("v_mbcnt_lo_u32_b32 %0, -1, 0\n\tv_mbcnt_hi_u32_b32 %0, -1, %0" : "=v"(lane_)); int bid_ = blockIdx.x; int wave_ = wave0; asm volatile("" : "+s"(bid_), "+s"(wave_)); const int lane = lane_, wave = wave_, tid = wave * 64 + lane, gw = bid_ * NWAVES + wave; (void)tid; \
    unsigned char* ws = p.ws; float* out = p.out; asm volatile("" : "+s"(ws), "+s"(out)); \
    float* scr = (float*)(lds_raw + wave * 16384); unsigned char* mb = ws + WS_R; bf16_t* U = (bf16_t*)(ws + WS_U); bf16_t* ACT = (bf16_t*)(ws + WS_R); \
    (void)lane; (void)gw; (void)scr; (void)mb; (void)U; (void)ACT;

    if (threadIdx.x == 0) { const unsigned x = (unsigned)__builtin_amdgcn_s_getreg((3 << 11) | 20) & 7u; bw_add((unsigned*)(p.ws + WS_CTL) + BW_XC(x)); }
    {
        PH
        float* cs = (float*)(ws + WS_CS);
        const int* pos = (const int*)p.in[1];
        for (int i = bid_ * NTHREADS + tid; i < T * 8; i += G * NTHREADS) {
            const int tok = i >> 3, f = i & 7;
            const float ang = (float)pos[tok] * ROPE_INV[f];
            double rev = (double)ang * 0.15915494309189535; rev -= floor(rev);
            const float rf = (float)rev;
            cs[(size_t)tok * 16 + f] = __builtin_amdgcn_cosf(rf); cs[(size_t)tok * 16 + 8 + f] = __builtin_amdgcn_sinf(rf);
        }
    }

    for (int layer = 0; layer < DEPTH; ++layer) {
        { PH
          if (PHM & 1) conv_ffn(p.in[3] + (size_t)layer * D * FF, p.in[4] + (size_t)layer * D * FF, p.in[5] + (size_t)layer * FF * D, ws, scr, gw, ngw, lane);
          if (PHM & 1) norm_rows_bf16(layer == 0 ? p.in[0] : out, p.in[2] + layer * D, U, gw, ngw, lane); }
        if (layer == 0) grid.sync(); else GBAR();
        { PH
          for (int rep = 0; rep < ((DUP & 1) ? 2 : 1); ++rep) { EpiFfnUp Ep{ACT}; run_gemm(lds, U, D, (const bf16_t*)(ws + WS_W13), T, 2 * FF, D, Ep, wave); } }
        GSYNC();
        { PH
          if (PHM & 4) { EpiResid Ep{layer == 0 ? p.in[0] : out, out, 0.5f}; run_gemm(lds, ACT, FF, (const bf16_t*)(ws + WS_W2), T, D, FF, Ep, wave); } }
        GSYNC();
        { PH
          if (PHM & 8) conv_mixer(p.in[7] + (size_t)layer * D * 5912, p.in[14] + (size_t)layer * D * 3072, p.in[15] + (size_t)layer * 1280 * D, p.in[16] + (size_t)layer * D * D,
                   p.in[9] + (size_t)layer * 2048 * 128, p.in[10] + (size_t)layer * 128 * 64, p.in[12] + (size_t)layer * 2048 * 128, p.in[13] + (size_t)layer * 128 * 64,
                   p.in[8] + (size_t)layer * 2048, p.in[11] + (size_t)layer * 2048, ws, scr, gw, ngw, lane);
          norm_rows_bf16(out, p.in[6] + layer * D, U, gw, ngw, lane); }
        GSYNC();
        for (int hf = 0; hf < NHF; ++hf) {
            { PH
              for (int rep = 0; rep < ((DUP & 2) ? 2 : 1); ++rep) { EpiInProj Ep{mb, (const float*)(ws + WS_CS) + (size_t)hf * TH * 16}; run_gemm(lds, U + (size_t)hf * TH * D, D, (const bf16_t*)(ws + WS_WIN), TH, NIN, D, Ep, wave); } }
            GSYNC();
            { PH
              if ((PHM & 0x1C0) != 0x1C0) { u32x4* Oz = (u32x4*)(mb + MB_O); for (size_t i = (size_t)bid_ * NTHREADS + tid; i < (size_t)TH * 1280 / 8; i += (size_t)G * NTHREADS) Oz[i] = (u32x4){0u, 0u, 0u, 0u}; }
              for (int it = gw; it < 7168; it += ngw) {
                  const unsigned char* sb; unsigned char* db; int dl = 0, hi, pb = it & 63; const int q = it >> 6;
                  if (q < 72) { const int g3 = q / 24; hi = q % 24; sb = mb + MB_VRM + (size_t)g3 * 12 * MiB; db = mb + MB_VA + (size_t)g3 * 12 * MiB; dl = 2 * g3; }
                  else if (q < 80) { hi = q - 72; sb = mb + MB_VRM + 36 * MiB; db = mb + MB_KV + 3 * 4 * MiB; }
                  else if (q < 88) { hi = q - 80; sb = mb + MB_VRM + 40 * MiB; db = mb + MB_KV + 5 * 4 * MiB; }
                  else { hi = q - 88; sb = mb + MB_VRM + 44 * MiB; db = mb + MB_VC; }
                  transpose_wave((const bf16_t*)sb + (size_t)hi * E, (bf16_t*)db + (size_t)hi * E, dl, pb, (bf16_t*)scr, lane);
              }
              for (int it = bid_; it < 256; it += G) { const int kv = it >> 7, hb = (it >> 5) & 3, gk = (it >> 4) & 1, rb = it & 15; compress_block(mb, ws, kv, hb, gk, rb, wave, lane, (LAS bf16_t*)(lds + 125952)); } }
            GSYNC();
            {
                PH
                LAS unsigned* sidx = (LAS unsigned*)(lds + LDS_MISC);
                const int xcd = bid_ & 7;
                unsigned* ctr = (unsigned*)(ws + WS_CTL) + ((layer * 2 + hf) * 8 + xcd) * 64;
                LAS float* sc = (LAS float*)lds;
                unsigned nxt = 0u; if (tid == 0) nxt = atomicAdd(ctr, 1u);
                for (;;) {
                    __syncthreads();
                    if (tid == 0) *sidx = nxt;
                    __syncthreads();
                    const int idx = (int)*sidx;
                    if (idx >= 320) break;
                    if (tid == 0) nxt = atomicAdd(ctr, 1u);
                    int ln = lane; asm volatile("" : "+v"(ln));
                    if (idx < 128) { const int qt = 127 - idx; attn_B_unit(mb, ws, xcd >> 1, xcd & 1, qt, wave, ln, sc, lds, (const float*)(ws + WS_CS) + (size_t)hf * TH * 16); }
                    else if (idx < 224) { const int i = idx - 128, pr = xcd * 3 + i / 32, j = i % 32; attn_A_wave(mb, pr / 6, pr % 6, j >> 1, (j & 1) * 8 + wave, ln, wave, lds); }
                    else { const int i = idx - 224, pr = xcd * 3 + i / 32, qb = 31 - (i % 32); attn_C_wave(mb, pr / 6, pr % 6, qb, wave, ln); }
                }
            }
            GSYNC();
            { PH
              if (PHM & 512) { EpiUpMerge<true> Ep{(const bf16_t*)(mb + MB_G), (bf16_t*)(mb + MB_Y)}; run_gemm(lds, (const bf16_t*)(mb + MB_O), 1280, (const bf16_t*)(ws + WS_WUP), TH, D, 384, Ep, wave); } }
            { PH
              if (PHM & 512) { EpiUpMerge<false> Ep{(const bf16_t*)(mb + MB_G) + 1024, (bf16_t*)(mb + MB_Y)}; run_gemm(lds, (const bf16_t*)(mb + MB_O) + 384, 1280, (const bf16_t*)(ws + WS_WUP) + 1024 * 384, TH, D, 512, Ep, wave); } }
            { PH
              if (PHM & 512) { EpiUpMerge<false> Ep{(const bf16_t*)(mb + MB_G) + 2048, (bf16_t*)(mb + MB_Y)}; run_gemm(lds, (const bf16_t*)(mb + MB_O) + 896, 1280, (const bf16_t*)(ws + WS_WUP) + 1024 * 896, TH, D, 384, Ep, wave); } }
            GSYNC();
            { PH
              if (PHM & 4) { float* hh = out + (size_t)hf * TH * D; EpiResid Ep{hh, hh, 1.0f}; run_gemm(lds, (const bf16_t*)(mb + MB_Y), D, (const bf16_t*)(ws + WS_WOUT), TH, D, D, Ep, wave); } }
            GSYNC();
        }
        { PH
          if (PHM & 1) conv_ffn(p.in[18] + (size_t)layer * D * FF, p.in[19] + (size_t)layer * D * FF, p.in[20] + (size_t)layer * FF * D, ws, scr, gw, ngw, lane);
          norm_rows_bf16(out, p.in[17] + layer * D, U, gw, ngw, lane); }
        GSYNC();
        { PH
          if (PHM & 2) { EpiFfnUp Ep{ACT}; run_gemm(lds, U, D, (const bf16_t*)(ws + WS_W13), T, 2 * FF, D, Ep, wave); } }
        GSYNC();
        { PH
          if (PHM & 4) { EpiResid Ep{out, out, 0.5f}; run_gemm(lds, ACT, FF, (const bf16_t*)(ws + WS_W2), T, D, FF, Ep, wave); } }
        GSYNC();
    }
    { PH
      norm_rows_f32_inplace(out, p.in[21], gw, ngw, lane); }
}

extern "C" void kernel_launch(void* const* d_in, const int* in_sizes, int n_in, void* d_out, int out_size, void* d_ws, size_t ws_size, hipStream_t stream) {
    static int grid_blocks = 0;
    if (grid_blocks == 0) {
        if (n_in != 22 || out_size != T * D || ws_size < WS_NEED) { fprintf(stderr, "kernel_launch: unexpected shapes (n_in %d out %d ws %zu, need %zu)\n", n_in, out_size, ws_size, (size_t)WS_NEED); grid_blocks = -1; return; }
        int dev = 0, cus = 0, per_cu = 0;
        hipGetDevice(&dev);
        hipDeviceGetAttribute(&cus, hipDeviceAttributeMultiprocessorCount, dev);
        if (hipFuncSetAttribute((const void*)hybrid_fwd, hipFuncAttributeMaxDynamicSharedMemorySize, LDS_BYTES) != hipSuccess) { fprintf(stderr, "kernel_launch: hipFuncSetAttribute failed\n"); grid_blocks = -1; return; }
        hipOccupancyMaxActiveBlocksPerMultiprocessor(&per_cu, (const void*)hybrid_fwd, NTHREADS, LDS_BYTES);
        if (per_cu < 1) { fprintf(stderr, "kernel_launch: occupancy query says %d blocks/CU\n", per_cu); per_cu = 1; }
        (void)hipGetLastError();
        grid_blocks = cus & ~7;
        if (grid_blocks < 8) { fprintf(stderr, "kernel_launch: needs at least 8 CUs\n"); grid_blocks = -1; return; }
    }
    if (grid_blocks < 0) return;
    hipMemsetAsync((char*)d_ws + WS_CTL, 0, 16384, stream);
    Params p{};
    for (int i = 0; i < 22; ++i) p.in[i] = (const float*)d_in[i];
    p.out = (float*)d_out; p.ws = (unsigned char*)d_ws;
    void* args[] = {&p};
    hipError_t e = hipLaunchCooperativeKernel((const void*)hybrid_fwd, dim3(grid_blocks), dim3(NTHREADS), args, LDS_BYTES, stream);
    if (e != hipSuccess) fprintf(stderr, "cooperative launch failed: %s (grid %d)\n", hipGetErrorString(e), grid_blocks);
}
```

```cpp
#include <hip/hip_runtime.h>
#include <hip/hip_cooperative_groups.h>
#include <cstdio>
#include <cstdint>
namespace cg = cooperative_groups;

namespace pg8 {
#define PG8_LAS __attribute__((address_space(3)))
typedef unsigned short bf16_t;
typedef short bf16x8 __attribute__((ext_vector_type(8)));
typedef float f32x4 __attribute__((ext_vector_type(4)));
typedef unsigned u32x4 __attribute__((ext_vector_type(4)));
constexpr int BM = 256, BK = 64, HALF = 128, HTB = HALF * BK * 2  , STAGE_BYTES = 8 * HTB, NXCD = 8, WGM = 8;

__host__ __device__ __forceinline__ int lds_byte(int r, int c) { const int st = (r >> 4) * 2 + (c >> 5), rr = r & 15, cc = c & 31, ob = rr * 64 + cc * 2; return st * 1024 + (ob ^ (((ob >> 9) & 1) << 5)); }
__host__ __device__ __forceinline__ void stage_rc(int b, int& R, int& C) { const int st = b / 1024, sb = b % 1024, swz = sb ^ (((sb >> 9) & 1) << 5); R = (st >> 1) * 16 + swz / 64; C = (st & 1) * 32 + (swz % 64) / 2; }
__host__ __device__ __forceinline__ int perm32(int rho) { const int n = rho >> 4, i = rho & 15; return 8 * (i >> 2) + 4 * n + (i & 3); }

struct Unit { int pm, pn; };
struct Gemm { const bf16_t* A; const bf16_t* Bt; int M, N, K, lda; };

struct StaticOrder {
    int nM, nN, nwg, G, c;
    __host__ __device__ void init(int M, int N, int G_, int c_) { nM = M / BM; nN = N / BM; nwg = nM * nN; G = G_; c = c_; }
    __host__ __device__ bool next(int i, Unit& u) const {
        const long L = (long)i * G + c; if (L >= nwg) return false;
        int wgid = (int)L; { const int q = nwg / NXCD, r = nwg % NXCD, xcd = wgid % NXCD, off = wgid / NXCD; wgid = (xcd < r ? xcd * (q + 1) : r * (q + 1) + (xcd - r) * q) + off; }
        const int nig = WGM * nN, gid = wgid / nig, fm = gid * WGM, gsz = (nM - fm) < WGM ? (nM - fm) : WGM;
        u.pm = fm + ((wgid % nig) % gsz); u.pn = (wgid % nig) / gsz; return true;
    }
    __device__ __forceinline__ void a_ready(const Unit&) const {}
    __device__ __forceinline__ void done(const Unit&) const {}
};

__device__ __forceinline__ unsigned cvt_pk_bf16(float lo, float hi) { unsigned r; asm volatile("v_cvt_pk_bf16_f32 %0, %1, %2" : "=v"(r) : "v"(lo), "v"(hi)); return r; }
typedef float f32x2 __attribute__((ext_vector_type(2)));
template <class Epi, class Sched, bool ALIGN_EPI = false, bool SP2 = false>
__device__ __forceinline__ void gemm_phase(PG8_LAS unsigned char* lds, const Gemm g, const Sched& S, const Epi& E, int wid_in) {
    int lane_l; asm volatile("v_mbcnt_lo_u32_b32 %0, -1, 0\n\tv_mbcnt_hi_u32_b32 %0, -1, %0" : "=v"(lane_l)); int tid_l = wid_in * 64 + lane_l;
    const int tid = tid_l, wid = __builtin_amdgcn_readfirstlane(tid >> 6), lane = tid & 63, wr = wid >> 2, wc = wid & 3, fr = lane & 15, fq = lane >> 4;
    const int K = g.K, nt = K / BK;
    unsigned voffA[2], voffB[2];
#pragma unroll
    for (int i = 0; i < 2; ++i) { int R, C; stage_rc(tid * 16 + i * 8192, R, C); const int Rb = Epi::PERM ? ((R & ~31) + perm32(R & 31)) : R;
        voffA[i] = (unsigned)(R * g.lda + C) * 2u; voffB[i] = (unsigned)(Rb * K + C) * 2u; }
    const size_t kstep = (size_t)(BK * 2);
    const size_t hstepA = (size_t)HALF * g.lda * 2, hstepB = (size_t)HALF * K * 2;
    const size_t tstepA = 2 * hstepA, tstepB = 2 * hstepB;
    const unsigned ldsw = (unsigned)wid * 1024u;
    const int aoff = lds_byte(wr * 64 + fr, fq * 8), boff = lds_byte(wc * 32 + fr, fq * 8);
#define PG8_SA(b, h) (((b) * 2 + (h)) * HTB)
#define PG8_SB(b, h) ((4 + (b) * 2 + (h)) * HTB)
#define PG8_STAGE(bufoff, gbase, voff) do { _Pragma("unroll") for (int _i = 0; _i < 2; ++_i) \
        __builtin_amdgcn_global_load_lds((const unsigned*)((const char*)(gbase) + (voff)[_i]), (PG8_LAS unsigned*)(lds + (bufoff) + ldsw + _i * 8192), 16, 0, 0); } while (0)
#define PG8_LDA(dst, b, h) do { _Pragma("unroll") for (int m = 0; m < 4; ++m) _Pragma("unroll") for (int k = 0; k < 2; ++k) dst[m][k] = *(const PG8_LAS bf16x8*)(lds + PG8_SA(b, h) + aoff + m * 2048 + k * 1024); } while (0)
#define PG8_LDB(dst, b, h) do { _Pragma("unroll") for (int n = 0; n < 2; ++n) _Pragma("unroll") for (int k = 0; k < 2; ++k) dst[n][k] = *(const PG8_LAS bf16x8*)(lds + PG8_SB(b, h) + boff + n * 2048 + k * 1024); } while (0)
#define PG8_MMA(ai, bj, At, Bt) do { __builtin_amdgcn_s_setprio(1); _Pragma("unroll") for (int m = 0; m < 4; ++m) _Pragma("unroll") for (int n = 0; n < 2; ++n) _Pragma("unroll") for (int k = 0; k < 2; ++k) \
        acc[ai][bj][m][n] = __builtin_amdgcn_mfma_f32_16x16x32_bf16(Bt[n][k], At[m][k], acc[ai][bj][m][n], 0, 0, 0); __builtin_amdgcn_s_setprio(0); } while (0)
#define PG8_WAIT_V(n) asm volatile("s_waitcnt vmcnt(" #n ")" ::: "memory")
#define PG8_WAIT_L(n) asm volatile("s_waitcnt lgkmcnt(" #n ")" ::: "memory")
#define PG8_BAR __builtin_amdgcn_s_barrier()
#define PG8_SCHED __builtin_amdgcn_sched_barrier(0)
    Unit cur, nxt; int ui = 0;
    if (!S.next(0, cur)) return;
    f32x4 acc[2][2][4][2];
#pragma unroll
    for (int a = 0; a < 2; ++a)
#pragma unroll
        for (int b = 0; b < 2; ++b)
#pragma unroll
            for (int m = 0; m < 4; ++m)
#pragma unroll
                for (int n = 0; n < 2; ++n) acc[a][b][m][n] = (f32x4){0.f, 0.f, 0.f, 0.f};
    bf16x8 At[4][2], B0[2][2], B1[2][2];
    const char* cA = (const char*)g.A + (size_t)cur.pm * tstepA; const char* cB = (const char*)g.Bt + (size_t)cur.pn * tstepB;
    S.a_ready(cur);
    if constexpr (SP2) {
        PG8_STAGE(PG8_SB(0, 0), cB, voffB); PG8_STAGE(PG8_SB(0, 1), cB + hstepB, voffB); PG8_STAGE(PG8_SA(0, 0), cA, voffA); PG8_STAGE(PG8_SA(0, 1), cA + hstepA, voffA);
        if (wr == 1) PG8_BAR;
        PG8_WAIT_V(2); PG8_BAR;
        PG8_STAGE(PG8_SB(1, 0), cB + kstep, voffB); PG8_STAGE(PG8_SA(1, 0), cA + kstep, voffA); PG8_STAGE(PG8_SB(1, 1), cB + hstepB + kstep, voffB);
        PG8_WAIT_V(6); PG8_BAR;
    } else {
        PG8_STAGE(PG8_SB(0, 0), cB, voffB); PG8_STAGE(PG8_SA(0, 0), cA, voffA); PG8_STAGE(PG8_SB(0, 1), cB + hstepB, voffB); PG8_STAGE(PG8_SA(0, 1), cA + hstepA, voffA);
        if (wr == 1) PG8_BAR;
        PG8_WAIT_V(4); PG8_BAR;
        PG8_STAGE(PG8_SB(1, 0), cB + kstep, voffB); PG8_STAGE(PG8_SA(1, 0), cA + kstep, voffA); PG8_STAGE(PG8_SB(1, 1), cB + hstepB + kstep, voffB);
        PG8_WAIT_V(6); PG8_BAR;
    }
    for (;;) {
        const bool has_next = S.next(ui + 1, nxt);
        const char* nA = has_next ? (const char*)g.A + (size_t)nxt.pm * tstepA : cA; const char* nB = has_next ? (const char*)g.Bt + (size_t)nxt.pn * tstepB : cB;
        for (int t = 0; t < nt; t += 2) {
            const bool last = (t == nt - 2);
            const char* a1 = cA + (size_t)(t + 1) * kstep;
            const char* a2 = last ? nA : cA + (size_t)(t + 2) * kstep; const char* b2 = last ? nB : cB + (size_t)(t + 2) * kstep;
            const char* a3 = a2 + kstep; const char* b3 = b2 + kstep;
            if (last && has_next) S.a_ready(nxt);
            if constexpr (SP2) {
            PG8_LDB(B0, 0, 0); PG8_LDB(B1, 0, 1); PG8_SCHED; PG8_LDA(At, 0, 0); PG8_STAGE(PG8_SA(1, 1), a1 + hstepA, voffA);
            PG8_WAIT_V(8); PG8_WAIT_L(0); PG8_BAR; PG8_MMA(0, 0, At, B0); PG8_MMA(0, 1, At, B1); PG8_BAR; PG8_SCHED;
            PG8_LDA(At, 0, 1); PG8_STAGE(PG8_SB(0, 0), b2, voffB); PG8_STAGE(PG8_SB(0, 1), b2 + hstepB, voffB); PG8_STAGE(PG8_SA(0, 0), a2, voffA);
            PG8_WAIT_V(8); PG8_WAIT_L(0); PG8_BAR; PG8_MMA(1, 0, At, B0); PG8_MMA(1, 1, At, B1); PG8_BAR; PG8_SCHED;
            PG8_LDB(B0, 1, 0); PG8_LDB(B1, 1, 1); PG8_SCHED; PG8_LDA(At, 1, 0); PG8_STAGE(PG8_SA(0, 1), a2 + hstepA, voffA);
            PG8_WAIT_V(8); PG8_WAIT_L(0); PG8_BAR; PG8_MMA(0, 0, At, B0); PG8_MMA(0, 1, At, B1); PG8_BAR; PG8_SCHED;
            PG8_LDA(At, 1, 1); PG8_STAGE(PG8_SB(1, 0), b3, voffB); PG8_STAGE(PG8_SB(1, 1), b3 + hstepB, voffB); PG8_STAGE(PG8_SA(1, 0), a3, voffA);
            PG8_WAIT_V(8); PG8_WAIT_L(0); PG8_BAR; PG8_MMA(1, 0, At, B0); PG8_MMA(1, 1, At, B1); PG8_BAR; PG8_SCHED;
            } else {
            PG8_LDB(B0, 0, 0); PG8_SCHED; PG8_LDA(At, 0, 0); PG8_STAGE(PG8_SA(1, 1), a1 + hstepA, voffA);
            PG8_WAIT_L(8); PG8_BAR; PG8_WAIT_L(0); PG8_MMA(0, 0, At, B0); PG8_BAR; PG8_SCHED;
            PG8_LDB(B1, 0, 1); PG8_STAGE(PG8_SB(0, 0), b2, voffB);
            PG8_BAR; PG8_WAIT_L(0); PG8_MMA(0, 1, At, B1); PG8_BAR;
            PG8_LDA(At, 0, 1); PG8_STAGE(PG8_SA(0, 0), a2, voffA);
            PG8_BAR; PG8_WAIT_L(0); PG8_MMA(1, 0, At, B0); PG8_BAR; PG8_SCHED;
            PG8_STAGE(PG8_SB(0, 1), b2 + hstepB, voffB);
            PG8_WAIT_V(6); PG8_BAR; PG8_MMA(1, 1, At, B1); PG8_BAR;
            PG8_LDB(B0, 1, 0); PG8_SCHED; PG8_LDA(At, 1, 0); PG8_STAGE(PG8_SA(0, 1), a2 + hstepA, voffA);
            PG8_WAIT_L(8); PG8_BAR; PG8_WAIT_L(0); PG8_MMA(0, 0, At, B0); PG8_BAR; PG8_SCHED;
            PG8_LDB(B1, 1, 1); PG8_STAGE(PG8_SB(1, 0), b3, voffB);
            PG8_BAR; PG8_WAIT_L(0); PG8_MMA(0, 1, At, B1); PG8_BAR;
            PG8_LDA(At, 1, 1); PG8_STAGE(PG8_SA(1, 0), a3, voffA);
            PG8_BAR; PG8_WAIT_L(0); PG8_MMA(1, 0, At, B0); PG8_BAR; PG8_SCHED;
            PG8_STAGE(PG8_SB(1, 1), b3 + hstepB, voffB);
            PG8_WAIT_V(6); PG8_BAR; PG8_MMA(1, 1, At, B1); PG8_BAR;
            }
        }
        if constexpr (ALIGN_EPI) { if (wr == 0) PG8_BAR; }
        if constexpr (!Epi::AFTER_DRAIN) { E(acc, cur, wr, wc, fr, fq); S.done(cur); }
        if (!has_next) break;
#pragma unroll
        for (int a = 0; a < 2; ++a)
#pragma unroll
            for (int b = 0; b < 2; ++b)
#pragma unroll
                for (int m = 0; m < 4; ++m)
#pragma unroll
                    for (int n = 0; n < 2; ++n) acc[a][b][m][n] = (f32x4){0.f, 0.f, 0.f, 0.f};
        cur = nxt; cA = nA; cB = nB; ++ui;
        if constexpr (ALIGN_EPI) { if (wr == 1) PG8_BAR; }
    }
    PG8_WAIT_V(0);
    if constexpr (!ALIGN_EPI) { if (wr == 0) PG8_BAR; }
    PG8_BAR;
    if constexpr (Epi::AFTER_DRAIN) { E.fused(acc, cur, wr, wc, fr, fq, lds, wid, lane); S.done(cur); }
#undef PG8_SA
#undef PG8_SB
#undef PG8_STAGE
#undef PG8_LDA
#undef PG8_LDB
#undef PG8_MMA
#undef PG8_WAIT_V
#undef PG8_WAIT_L
#undef PG8_BAR
#undef PG8_SCHED
}
}


typedef unsigned short bf16_t;
typedef short bf16x8 __attribute__((ext_vector_type(8)));
typedef float f32x4 __attribute__((ext_vector_type(4)));
typedef unsigned u32x4 __attribute__((ext_vector_type(4)));
typedef unsigned u32x2 __attribute__((ext_vector_type(2)));
#define LAS __attribute__((address_space(3)))

constexpr int NB = 8, S = 4096, T = NB * S, D = 1024, FF = 2816, DEPTH = 2;
constexpr int HBAT = 4, TH = HBAT * S;
constexpr int NIN = 9216, NPROJ = 6144;
constexpr size_t MiB = 1u << 20;
constexpr size_t E = (size_t)S * 64;
constexpr int NTHREADS = 512, NWAVES = 8;
constexpr int LDS_BYTES = 132 * 1024;
constexpr int LDS_MISC = 131072;

constexpr size_t WS_CTL = 0;
constexpr size_t WS_CS = 1 * MiB;
constexpr size_t WS_W13 = 3 * MiB;
constexpr size_t WS_W2 = 14 * MiB;
constexpr size_t WS_WIN = 20 * MiB;
constexpr size_t WS_WUP = 39 * MiB;
constexpr size_t WS_WOUT = 42 * MiB;
constexpr size_t WS_CW1 = 44 * MiB;
constexpr size_t WS_CW2 = 45 * MiB;
constexpr size_t WS_KC = 46 * MiB;
constexpr size_t WS_U = 48 * MiB;
constexpr size_t WS_R = 112 * MiB;
constexpr size_t MB_QA = 0, MB_KA = 36 * MiB, MB_VA = 72 * MiB;
constexpr size_t MB_QB = 108 * MiB, MB_QBR = 124 * MiB;
constexpr size_t MB_KV = 140 * MiB;
constexpr size_t MB_GB = 164 * MiB;
constexpr size_t MB_QC = 166 * MiB, MB_KC = 178 * MiB, MB_VC = 190 * MiB;
constexpr size_t MB_G = 202 * MiB;
constexpr size_t MB_O = 298 * MiB;
constexpr size_t MB_Y = MB_QA;
constexpr size_t MB_VRM = 338 * MiB;
constexpr size_t WS_NEED = WS_R + 394 * MiB;

__constant__ float ROPE_INV[8] = {1.0f, 0.1939227432012558f, 0.03760603070259094f, 0.007292664609849453f,
                                  0.0014142135623842478f, 0.00027424818836152554f, 5.318296098266728e-05f, 1.0313386155758053e-05f};

typedef float f32x2_t __attribute__((ext_vector_type(2)));
typedef __bf16 bf16x2_t __attribute__((ext_vector_type(2)));
__device__ __forceinline__ unsigned pk_bf16(float lo, float hi) { f32x2_t v = {lo, hi}; bf16x2_t b = __builtin_convertvector(v, bf16x2_t); return __builtin_bit_cast(unsigned, b); }
__device__ __forceinline__ float bflo(unsigned w) { return __builtin_bit_cast(float, w << 16); }
__device__ __forceinline__ float bfhi(unsigned w) { return __builtin_bit_cast(float, w & 0xffff0000u); }
__device__ __forceinline__ float fexp2(float x) { return __builtin_amdgcn_exp2f(x); }
__device__ __forceinline__ float flog2(float x) { return __builtin_amdgcn_logf(x); }
__device__ __forceinline__ float frcp(float x) { return __builtin_amdgcn_rcpf(x); }
__device__ __forceinline__ bf16x8 pack8(f32x4 a, f32x4 b) {
    u32x4 w; w.x = pk_bf16(a[0], a[1]); w.y = pk_bf16(a[2], a[3]); w.z = pk_bf16(b[0], b[1]); w.w = pk_bf16(b[2], b[3]);
    return __builtin_bit_cast(bf16x8, w);
}
__device__ __forceinline__ bf16x8 ld16(const bf16_t* p) { return *(const bf16x8*)p; }
__device__ __forceinline__ f32x4 mfma16(bf16x8 a, bf16x8 b, f32x4 c) { return __builtin_amdgcn_mfma_f32_16x16x32_bf16(a, b, c, 0, 0, 0); }
__device__ __forceinline__ int perm32pos(int p) { return (p & ~31) | ((((p & 15) >> 2) << 3) + (((p >> 4) & 1) << 2) + (p & 3)); }
__device__ __forceinline__ float shx(float v, int mask, int lane) { return __builtin_bit_cast(float, __builtin_amdgcn_ds_bpermute((lane ^ mask) << 2, __builtin_bit_cast(int, v))); }
__device__ __forceinline__ float shi(float v, int src) { return __builtin_bit_cast(float, __builtin_amdgcn_ds_bpermute(src << 2, __builtin_bit_cast(int, v))); }
__device__ __forceinline__ float qx1(float v) { return __builtin_bit_cast(float, __builtin_amdgcn_update_dpp(0, __builtin_bit_cast(int, v), 0xB1, 0xF, 0xF, true)); }
__device__ __forceinline__ float qx2(float v) { return __builtin_bit_cast(float, __builtin_amdgcn_update_dpp(0, __builtin_bit_cast(int, v), 0x4E, 0xF, 0xF, true)); }
constexpr float LOG2E = 1.4426950408889634f, LN2 = 0.6931471805599453f;

struct EpiFfnUp {
    static constexpr bool PERM = true, AFTER_DRAIN = false;
    bf16_t* O;
    __device__ __forceinline__ void operator()(const f32x4 (&acc)[2][2][4][2], const pg8::Unit& u, int wr, int wc, int fr_in, int fq_in) const {
        int lane_e; asm volatile("v_mbcnt_lo_u32_b32 %0, -1, 0\n\tv_mbcnt_hi_u32_b32 %0, -1, %0" : "=v"(lane_e)); const int fr = lane_e & 15, fq = lane_e >> 4; (void)fr_in; (void)fq_in;
        const int row0 = u.pm * 256 + wr * 64 + fr, col0 = u.pn * 128 + wc * 32 + 8 * fq;
        bf16_t* rowp = O + (size_t)row0 * FF + col0;
#pragma unroll
        for (int ai = 0; ai < 2; ++ai) {
#pragma unroll
            for (int m = 0; m < 4; ++m) {
                float r[8];
#pragma unroll
                for (int e = 0; e < 8; ++e) { const float a = acc[ai][0][m][e >> 2][e & 3], b = acc[ai][1][m][e >> 2][e & 3]; r[e] = a * frcp(1.f + fexp2(-a * LOG2E)) * b; }
                u32x4 w; w.x = pk_bf16(r[0], r[1]); w.y = pk_bf16(r[2], r[3]); w.z = pk_bf16(r[4], r[5]); w.w = pk_bf16(r[6], r[7]);
                __builtin_nontemporal_store(w, (u32x4*)rowp);
                rowp += (size_t)16 * FF; asm volatile("" : "+v"(rowp)); }
            rowp += (size_t)64 * FF; asm volatile("" : "+v"(rowp)); }
    }
};
struct EpiResid {
    static constexpr bool PERM = true, AFTER_DRAIN = false;
    const float* src; float* dst; float scale;
    __device__ __forceinline__ void operator()(const f32x4 (&acc)[2][2][4][2], const pg8::Unit& u, int wr, int wc, int fr_in, int fq_in) const {
        int lane_e; asm volatile("v_mbcnt_lo_u32_b32 %0, -1, 0\n\tv_mbcnt_hi_u32_b32 %0, -1, %0" : "=v"(lane_e)); const int fr = lane_e & 15, fq = lane_e >> 4; (void)fr_in; (void)fq_in;
        const int row0 = u.pm * 256 + wr * 64 + fr, col0 = u.pn * 256 + wc * 32 + 8 * fq;
        const float* sp = src + (size_t)row0 * D + col0; float* dp = dst + (size_t)row0 * D + col0;
#pragma unroll
        for (int ai = 0; ai < 2; ++ai) {
            f32x4 sv[4][2][2];
#pragma unroll
            for (int m = 0; m < 4; ++m)
#pragma unroll
                for (int bj = 0; bj < 2; ++bj) { sv[m][bj][0] = *(const f32x4*)(sp + m * 16 * D + bj * 128); sv[m][bj][1] = *(const f32x4*)(sp + m * 16 * D + bj * 128 + 4); }
#pragma unroll
            for (int m = 0; m < 4; ++m)
#pragma unroll
                for (int bj = 0; bj < 2; ++bj) { *(f32x4*)(dp + m * 16 * D + bj * 128) = sv[m][bj][0] + acc[ai][bj][m][0] * scale; *(f32x4*)(dp + m * 16 * D + bj * 128 + 4) = sv[m][bj][1] + acc[ai][bj][m][1] * scale; }
            sp += 128 * D; dp += 128 * D; asm volatile("" : "+v"(sp), "+v"(dp)); }
    }
};
template <bool FIRST> struct EpiUpMerge {
    static constexpr bool PERM = true, AFTER_DRAIN = false;
    const bf16_t* G; bf16_t* Y;
    __device__ __forceinline__ void operator()(const f32x4 (&acc)[2][2][4][2], const pg8::Unit& u, int wr, int wc, int fr_in, int fq_in) const {
        int lane_e; asm volatile("v_mbcnt_lo_u32_b32 %0, -1, 0\n\tv_mbcnt_hi_u32_b32 %0, -1, %0" : "=v"(lane_e)); const int fr = lane_e & 15, fq = lane_e >> 4; (void)fr_in; (void)fq_in;
        const int row0 = u.pm * 256 + wr * 64 + fr, col0 = u.pn * 256 + wc * 32 + 8 * fq;
        const bf16_t* gp = G + (size_t)row0 * 3072 + col0; bf16_t* yp = Y + (size_t)row0 * D + col0;
#pragma unroll
        for (int ai = 0; ai < 2; ++ai) {
            u32x4 gv[4][2], yv[4][2];
#pragma unroll
            for (int m = 0; m < 4; ++m)
#pragma unroll
                for (int bj = 0; bj < 2; ++bj) { gv[m][bj] = *(const u32x4*)(gp + m * 16 * 3072 + bj * 128); if (!FIRST) yv[m][bj] = *(const u32x4*)(yp + m * 16 * D + bj * 128); }
#pragma unroll
            for (int m = 0; m < 4; ++m)
#pragma unroll
                for (int bj = 0; bj < 2; ++bj) {
                    const f32x4 a0 = acc[ai][bj][m][0], a1 = acc[ai][bj][m][1];
                    f32x4 y0 = {0.f, 0.f, 0.f, 0.f}, y1 = {0.f, 0.f, 0.f, 0.f};
                    if (!FIRST) { const u32x4 t = yv[m][bj]; y0 = (f32x4){bflo(t.x), bfhi(t.x), bflo(t.y), bfhi(t.y)}; y1 = (f32x4){bflo(t.z), bfhi(t.z), bflo(t.w), bfhi(t.w)}; }
                    const u32x4 g4 = gv[m][bj];
                    y0 += (f32x4){bflo(g4.x), bfhi(g4.x), bflo(g4.y), bfhi(g4.y)} * a0;
                    y1 += (f32x4){bflo(g4.z), bfhi(g4.z), bflo(g4.w), bfhi(g4.w)} * a1;
                    u32x4 w; w.x = pk_bf16(y0[0], y0[1]); w.y = pk_bf16(y0[2], y0[3]); w.z = pk_bf16(y1[0], y1[1]); w.w = pk_bf16(y1[2], y1[3]);
                    *(u32x4*)(yp + m * 16 * D + bj * 128) = w; }
            gp += 128 * 3072; yp += 128 * D; asm volatile("" : "+v"(gp), "+v"(yp)); }
    }
};
struct EpiInProj {
    static constexpr bool PERM = true, AFTER_DRAIN = false;
    unsigned char* mb; const float* cs;
    __device__ __forceinline__ void operator()(const f32x4 (&acc)[2][2][4][2], const pg8::Unit& u, int wr, int wc, int fr_in, int fq_in) const {
        int lane_e; asm volatile("v_mbcnt_lo_u32_b32 %0, -1, 0\n\tv_mbcnt_hi_u32_b32 %0, -1, %0" : "=v"(lane_e)); const int fr = lane_e & 15, fq = lane_e >> 4; (void)fr_in; (void)fq_in;
        const int row0 = u.pm * 256 + wr * 64 + fr;
#pragma unroll
        for (int bj = 0; bj < 2; ++bj) {
            const int cb = u.pn * 256 + bj * 128 + wc * 32;
            const int hc = cb >> 6;
            if (hc >= 93 && hc < 96) continue;
            const int dd = (cb & 63) + 8 * fq;
            if (hc >= 96) {
                bf16_t* G = (bf16_t*)(mb + MB_G);
#pragma unroll
                for (int ai = 0; ai < 2; ++ai)
#pragma unroll
                    for (int m = 0; m < 4; ++m) { const size_t row = (size_t)(row0 + ai * 128 + m * 16); float v[8];
#pragma unroll
                        for (int e = 0; e < 8; ++e) { const float x = acc[ai][bj][m][e >> 2][e & 3]; v[e] = frcp(1.f + fexp2(-x * LOG2E)); }
                        u32x4 w; w.x = pk_bf16(v[0], v[1]); w.y = pk_bf16(v[2], v[3]); w.z = pk_bf16(v[4], v[5]); w.w = pk_bf16(v[6], v[7]);
                        __builtin_nontemporal_store(w, (u32x4*)(G + row * 3072 + (cb - NPROJ) + 8 * fq)); }
                continue;
            }
            if (hc == 74) {
                float* GBp = (float*)(mb + MB_GB);
                if (dd < 24) {
#pragma unroll
                    for (int ai = 0; ai < 2; ++ai)
#pragma unroll
                        for (int m = 0; m < 4; ++m) { const size_t row = (size_t)(row0 + ai * 128 + m * 16);
#pragma unroll
                            for (int e = 0; e < 8; ++e) { const float x = acc[ai][bj][m][e >> 2][e & 3]; GBp[row * 24 + dd + e] = frcp(1.f + fexp2(-x * LOG2E)); } }
                }
                continue;
            }
            size_t boff; int nh, hd, dl = 0; bool rope = false, tr = false;
            if (hc < 54) { const int g = hc / 18, kd = (hc % 18) / 6; hd = hc % 6; nh = 6; boff = (kd == 0 ? MB_QA : (kd == 1 ? MB_KA : MB_VRM)) + (size_t)g * 12 * MiB; rope = kd < 2; }
            else if (hc < 62) { boff = MB_QB; nh = 8; hd = hc - 54; }
            else if (hc < 74) { const int idx = hc - 62, br = idx >> 2, kvt = (idx >> 1) & 1; hd = idx & 1; nh = 2; boff = (kvt == 1 && br >= 1) ? MB_VRM + (size_t)(32 + 4 * br) * MiB : MB_KV + (size_t)(br * 2 + kvt) * 4 * MiB; rope = (kvt == 0 && br >= 1); }
            else { const int idx = hc - 75, kd = idx / 6; hd = idx % 6; nh = 6; boff = kd == 0 ? MB_QC : (kd == 1 ? MB_KC : MB_VRM + 44 * MiB); }
            bf16_t* base = (bf16_t*)(mb + boff);
            const bool dorope = rope && ((cb & 63) == 0);
#pragma unroll
            for (int ai = 0; ai < 2; ++ai) {
                f32x4 cv[4][4];
                if (dorope) {
#pragma unroll
                    for (int m = 0; m < 4; ++m) { const f32x4* c = (const f32x4*)(cs + (size_t)(row0 + ai * 128 + m * 16) * 16); cv[m][0] = c[0]; cv[m][1] = c[1]; cv[m][2] = c[2]; cv[m][3] = c[3]; }
                }
#pragma unroll
                for (int m = 0; m < 4; ++m) {
                    const int row = row0 + ai * 128 + m * 16; const int hb = row >> 12, t = row & (S - 1);
                    float v[8];
#pragma unroll
                    for (int e = 0; e < 8; ++e) v[e] = acc[ai][bj][m][e >> 2][e & 3];
                    if (dorope) {
#pragma unroll
                        for (int e = 0; e < 8; ++e) { const float other = shx(v[e], 16, fr + 16 * fq);
                            if (fq < 2) { const float co = cv[m][e >> 2][e & 3], si = cv[m][2 + (e >> 2)][e & 3]; v[e] = (fq == 0) ? (v[e] * co - other * si) : (v[e] * co + other * si); } }
                    }
                    u32x4 w; w.x = pk_bf16(v[0], v[1]); w.y = pk_bf16(v[2], v[3]); w.z = pk_bf16(v[4], v[5]); w.w = pk_bf16(v[6], v[7]);
                    __builtin_nontemporal_store(w, (u32x4*)(base + ((size_t)(hb * nh + hd) * S + t) * 64 + dd));
                }
            }
        }
    }
};
__device__ __forceinline__ int in_orig_col(int n) {
    const int hc = n >> 6, d = n & 63;
    if (hc < 54) { const int g = hc / 18, kd = (hc % 18) / 6, slot = hc % 6; return ((kd * 3 + g) * 6 + slot) * 64 + d; }
    if (hc < 62) return 3456 + (hc - 54) * 64 + d;
    if (hc < 74) return 3968 + (hc - 62) * 64 + d;
    if (hc == 74) return d < 24 ? 4736 + d : -1;
    if (hc < 93) return 4760 + (hc - 75) * 64 + d;
    return -1;
}

template <class Epi> __device__ __forceinline__ void run_gemm(LAS unsigned char* lds, const bf16_t* A, int lda, const bf16_t* Bt, int M, int N, int K, const Epi& Ep, int wid_in) {
    int bid = blockIdx.x; asm volatile("" : "+s"(A), "+s"(Bt), "+s"(bid));
    pg8::Gemm g{A, Bt, M, N, K, lda}; pg8::StaticOrder So; So.init(M, N, (int)gridDim.x, bid);
    pg8::gemm_phase<Epi, pg8::StaticOrder, true, true>(lds, g, So, Ep, wid_in);
}

struct AState { f32x4 o[4]; float m, l; };
__device__ __forceinline__ void st_init(AState& a) {
#pragma unroll
    for (int i = 0; i < 4; ++i) a.o[i] = (f32x4){0.f, 0.f, 0.f, 0.f};
    a.m = -1e30f; a.l = 0.f;
}
struct KV { bf16x8 k[4][2]; bf16x8 v[4][2]; };
__device__ __forceinline__ void load_kv(KV& t, const bf16_t* k0, size_t kstride, const bf16_t* vb, size_t vpitch, int g) {
#pragma unroll
    for (int kt = 0; kt < 4; ++kt) { const bf16_t* kr = k0 + kt * kstride; t.k[kt][0] = ld16(kr + 8 * g); t.k[kt][1] = ld16(kr + 32 + 8 * g); }
#pragma unroll
    for (int dt = 0; dt < 4; ++dt)
#pragma unroll
        for (int c = 0; c < 2; ++c) t.v[dt][c] = ld16(vb + (size_t)(16 * dt) * vpitch + c * 32);
}
__device__ __forceinline__ void qk_compute(f32x4 (&s)[4], const KV& t, const bf16x8 (&qf)[2]) {
#pragma unroll
    for (int kt = 0; kt < 4; ++kt) { s[kt] = mfma16(t.k[kt][0], qf[0], (f32x4){0.f, 0.f, 0.f, 0.f}); s[kt] = mfma16(t.k[kt][1], qf[1], s[kt]); }
}
__device__ __forceinline__ void softmax_pv(AState& a, f32x4 (&s)[4], unsigned vm, const bf16x8 (&vf)[4][2], int lane) {
    const float C2 = 0.125f * LOG2E;
    float mx = -1e30f;
#pragma unroll
    for (int kt = 0; kt < 4; ++kt)
#pragma unroll
        for (int j = 0; j < 4; ++j) { const float v = ((vm >> (kt * 4 + j)) & 1u) ? s[kt][j] * C2 : -1e30f; s[kt][j] = v; mx = fmaxf(mx, v); }
    mx = fmaxf(mx, shx(mx, 16, lane)); mx = fmaxf(mx, shx(mx, 32, lane));
    const float mn = fmaxf(a.m, mx);
    const float alpha = fexp2(a.m - mn);
    a.m = mn;
    float ps = 0.f;
#pragma unroll
    for (int kt = 0; kt < 4; ++kt)
#pragma unroll
        for (int j = 0; j < 4; ++j) { const float p = ((vm >> (kt * 4 + j)) & 1u) ? fexp2(s[kt][j] - mn) : 0.f; s[kt][j] = p; ps += p; }
    a.l = a.l * alpha + ps;
    const bf16x8 p0 = pack8(s[0], s[1]), p1 = pack8(s[2], s[3]);
#pragma unroll
    for (int dt = 0; dt < 4; ++dt) { a.o[dt] = a.o[dt] * alpha; a.o[dt] = mfma16(vf[dt][0], p0, a.o[dt]); a.o[dt] = mfma16(vf[dt][1], p1, a.o[dt]); }
}
__device__ __forceinline__ void softmax_pv_nomask(AState& a, f32x4 (&s)[4], float bias, const bf16x8 (&vf)[4][2], int lane) {
    const float C2 = 0.125f * LOG2E;
    float mx = -1e30f;
#pragma unroll
    for (int kt = 0; kt < 4; ++kt)
#pragma unroll
        for (int j = 0; j < 4; ++j) { const float v = fmaf(s[kt][j], C2, bias); s[kt][j] = v; mx = fmaxf(mx, v); }
    mx = fmaxf(mx, shx(mx, 16, lane)); mx = fmaxf(mx, shx(mx, 32, lane));
    const float mn = fmaxf(a.m, mx);
    const float alpha = fexp2(a.m - mn);
    a.m = mn;
    float ps = 0.f;
#pragma unroll
    for (int kt = 0; kt < 4; ++kt)
#pragma unroll
        for (int j = 0; j < 4; ++j) { const float p = fexp2(s[kt][j] - mn); s[kt][j] = p; ps += p; }
    a.l = a.l * alpha + ps;
    const bf16x8 p0 = pack8(s[0], s[1]), p1 = pack8(s[2], s[3]);
#pragma unroll
    for (int dt = 0; dt < 4; ++dt) { a.o[dt] = a.o[dt] * alpha; a.o[dt] = mfma16(vf[dt][0], p0, a.o[dt]); a.o[dt] = mfma16(vf[dt][1], p1, a.o[dt]); }
}
__device__ __forceinline__ float st_inv_l(const AState& a, int lane) {
    float l = a.l; l += shx(l, 16, lane); l += shx(l, 32, lane);
    return l > 0.f ? 1.f / l : 0.f;
}
__device__ __forceinline__ void store_o(bf16_t* dst  , const f32x4 (&o)[4], int g) {
#pragma unroll
    for (int dt = 0; dt < 4; ++dt) { u32x2 w; w.x = pk_bf16(o[dt][0], o[dt][1]); w.y = pk_bf16(o[dt][2], o[dt][3]); __builtin_nontemporal_store(w, (u32x2*)(dst + 16 * dt + 4 * g)); }
}

struct Stg { bf16x8 k, v; };
__device__ __forceinline__ void stg_load(Stg& r, const bf16_t* K, const bf16_t* Vt, int kb, int tid) {
    const int row = tid >> 3, ch = tid & 7;
    r.k = ld16(K + (size_t)(64 * kb + row) * 64 + 8 * ch); r.v = ld16(Vt + (size_t)row * S + 64 * kb + 8 * ch);
}
__device__ __forceinline__ void stg_store(const Stg& r, LAS bf16_t* buf, int tid) {
    const int off = (tid >> 3) * 72 + 8 * (tid & 7);
    *(LAS bf16x8*)(buf + off) = r.k; *(LAS bf16x8*)(buf + 4608 + off) = r.v;
}
__device__ __forceinline__ void lds_frags(KV& t, const LAS bf16_t* buf, int li, int g) {
#pragma unroll
    for (int kt = 0; kt < 4; ++kt) { t.k[kt][0] = *(const LAS bf16x8*)(buf + (16 * kt + li) * 72 + 8 * g); t.k[kt][1] = *(const LAS bf16x8*)(buf + (16 * kt + li) * 72 + 32 + 8 * g); }
#pragma unroll
    for (int dt = 0; dt < 4; ++dt)
#pragma unroll
        for (int c = 0; c < 2; ++c) t.v[dt][c] = *(const LAS bf16x8*)(buf + 4608 + (16 * dt + li) * 72 + c * 32 + 8 * g);
}

__device__ __forceinline__ void attn_A_wave(const unsigned char* mb, int hb, int slot, int tblk, int r, int lane, int w, LAS unsigned char* ldsb) {
    const int g = lane >> 4, li = lane & 15;
    const int tq = 256 * tblk + r + 16 * li;
    AState st; st_init(st);
#pragma unroll
    for (int gi = 0; gi < 3; ++gi) {
        const int dl = 2 * gi, L = S >> dl;
        const int rho = r & ((1 << dl) - 1);
        const int mq = tq >> dl;
        const size_t hoff = (size_t)(hb * 6 + slot) * E;
        const bf16_t* Q = (const bf16_t*)(mb + MB_QA + (size_t)gi * 12 * MiB) + hoff;
        const bf16_t* K = (const bf16_t*)(mb + MB_KA + (size_t)gi * 12 * MiB) + hoff;
        const bf16_t* Vt = (const bf16_t*)(mb + MB_VA + (size_t)gi * 12 * MiB) + hoff;
        bf16x8 qf[2]; qf[0] = ld16(Q + (size_t)tq * 64 + 8 * g); qf[1] = ld16(Q + (size_t)tq * 64 + 32 + 8 * g);
        const int mq_min = (256 * tblk + r) >> dl, mq_max = (256 * tblk + r + 240) >> dl;
        const int tlo = (mq_min > 128 ? mq_min - 128 : 0) >> 6, thi = mq_max >> 6;
        if (gi == 0) {
            const int tid = w * 64 + lane;
            LAS bf16_t* tb0 = (LAS bf16_t*)(ldsb + 16384); LAS bf16_t* tb1 = tb0 + 9216;
            const int tlo0 = 4 * tblk - 2 > 0 ? 4 * tblk - 2 : 0, thi0 = 4 * tblk + 3;
            int cur = 0;
            { Stg r_; stg_load(r_, K, Vt, tlo0, tid); stg_store(r_, tb0, tid); }
            __syncthreads();
            for (int kb = tlo0; kb <= thi0; ++kb) {
                const bool hn = kb < thi0; Stg rn;
                if (hn) stg_load(rn, K, Vt, kb + 1, tid);
                { KV t; lds_frags(t, cur ? tb1 : tb0, li, g);
                  f32x4 s[4]; qk_compute(s, t, qf); unsigned vm = 0;
#pragma unroll
                  for (int kt = 0; kt < 4; ++kt)
#pragma unroll
                      for (int j = 0; j < 4; ++j) { const int dist = mq - (64 * kb + 16 * kt + 4 * g + j); if (dist >= 0 && dist <= 128) vm |= 1u << (kt * 4 + j); }
                  softmax_pv(st, s, vm, t.v, lane); }
                if (hn) stg_store(rn, cur ? tb0 : tb1, tid);
                __syncthreads();
                cur ^= 1;
            }
        } else {
        const bf16_t* kbase = K + (size_t)(rho + (li << dl)) * 64; const size_t ktile = (size_t)64 << (6 + dl), ksub = (size_t)16 << (6 + dl);
        const bf16_t* vbase = Vt + (size_t)li * S + rho * L + 8 * g;
#define A_LOAD(T, tl) load_kv(T, kbase + (size_t)(tl) * ktile, ksub, vbase + 64 * (tl), S, g)
#define A_STEP(T, tl) do { f32x4 s[4]; qk_compute(s, T, qf); unsigned vm = 0; _Pragma("unroll") for (int kt = 0; kt < 4; ++kt) _Pragma("unroll") for (int j = 0; j < 4; ++j) { \
            const int dist = mq - (64 * (tl) + 16 * kt + 4 * g + j); if (dist >= 0 && dist <= 128) vm |= 1u << (kt * 4 + j); } softmax_pv(st, s, vm, T.v, lane); } while (0)
        KV ta, tb;
        A_LOAD(ta, tlo);
        for (int tile = tlo; tile <= thi; tile += 2) {
            A_LOAD(tb, tile + 1 <= thi ? tile + 1 : thi);
            A_STEP(ta, tile);
            if (tile + 1 > thi) break;
            A_LOAD(ta, tile + 2 <= thi ? tile + 2 : thi);
            A_STEP(tb, tile + 1);
        }
#undef A_LOAD
#undef A_STEP
        }
    }
    const float inv = st_inv_l(st, lane);
#pragma unroll
    for (int dt = 0; dt < 4; ++dt) st.o[dt] = st.o[dt] * inv;
    store_o((bf16_t*)(mb + MB_O) + ((size_t)hb * S + tq) * 1280 + slot * 64, st.o, g);
}

__device__ __forceinline__ void attn_C_wave(const unsigned char* mb, int hb, int head, int qb, int w, int lane) {
    const int g = lane >> 4, li = lane & 15;
    const int tq = 128 * qb + 16 * w + li;
    const size_t hoff = (size_t)(hb * 6 + head) * E;
    const bf16_t* Q = (const bf16_t*)(mb + MB_QC) + hoff;
    const bf16_t* K = (const bf16_t*)(mb + MB_KC) + hoff;
    const bf16_t* Vt = (const bf16_t*)(mb + MB_VC) + hoff;
    bf16x8 qf[2]; qf[0] = ld16(Q + (size_t)tq * 64 + 8 * g); qf[1] = ld16(Q + (size_t)tq * 64 + 32 + 8 * g);
    f32x4 o[4];
#pragma unroll
    for (int i = 0; i < 4; ++i) o[i] = (f32x4){0.f, 0.f, 0.f, 0.f};
    float R = 0.f;
    const int thi = (128 * qb + 16 * w + 14) >> 6;
    const bf16_t* kbase = K + (size_t)li * 64; const bf16_t* vbase = Vt + (size_t)li * S + 8 * g;
#define C_LOAD(T, tl) load_kv(T, kbase + (size_t)(tl) * 4096, 1024, vbase + 64 * (tl), S, g)
#define C_STEP(T, tl) do { f32x4 s[4]; qk_compute(s, T, qf); f32x4 Lm[4], Lp[4]; float tot[4], sgt[4]; \
        _Pragma("unroll") for (int kt = 0; kt < 4; ++kt) { float gs = 0.f; \
            _Pragma("unroll") for (int j = 0; j < 4; ++j) { const int key = 64 * (tl) + 16 * kt + 4 * g + j; const bool valid = key < tq; \
                const float z = s[kt][j] * 0.125f; const float e = fexp2(-fabsf(z) * LOG2E); const float sp = fmaxf(z, 0.f) + flog2(1.f + e) * LN2; \
                Lm[kt][j] = valid ? -sp : 0.f; Lp[kt][j] = valid ? (z - sp) : -1e30f; gs += Lm[kt][j]; } \
            const float x1 = shx(gs, 16, lane), x2 = shx(gs, 32, lane), x3 = shx(gs, 48, lane); \
            tot[kt] = gs + x1 + x2 + x3; \
            sgt[kt] = (((g ^ 1) > g) ? x1 : 0.f) + (((g ^ 2) > g) ? x2 : 0.f) + (((g ^ 3) > g) ? x3 : 0.f); } \
        float off[4]; off[3] = R + sgt[3]; off[2] = R + tot[3] + sgt[2]; off[1] = R + tot[3] + tot[2] + sgt[1]; off[0] = R + tot[3] + tot[2] + tot[1] + sgt[0]; \
        R += tot[0] + tot[1] + tot[2] + tot[3]; \
        _Pragma("unroll") for (int kt = 0; kt < 4; ++kt) { float run = off[kt]; \
            _Pragma("unroll") for (int j = 3; j >= 0; --j) { const float a = fexp2((Lp[kt][j] + run) * LOG2E); run += Lm[kt][j]; s[kt][j] = a; } } \
        const bf16x8 p0 = pack8(s[0], s[1]), p1 = pack8(s[2], s[3]); \
        _Pragma("unroll") for (int dt = 0; dt < 4; ++dt) { o[dt] = mfma16(T.v[dt][0], p0, o[dt]); o[dt] = mfma16(T.v[dt][1], p1, o[dt]); } } while (0)
#define C_DONE() (__builtin_amdgcn_ballot_w64(R > -110.f) == 0ull)
    KV ta, tb;
    C_LOAD(ta, thi);
    for (int tile = thi; tile >= 0; tile -= 2) {
        C_LOAD(tb, tile >= 1 ? tile - 1 : 0);
        C_STEP(ta, tile);
        if (tile < 1 || C_DONE()) break;
        C_LOAD(ta, tile >= 2 ? tile - 2 : 0);
        C_STEP(tb, tile - 1);
        if (C_DONE()) break;
    }
#undef C_LOAD
#undef C_STEP
#undef C_DONE
    store_o((bf16_t*)(mb + MB_O) + ((size_t)hb * S + tq) * 1280 + 896 + head * 64, o, g);
}


__device__ __forceinline__ void attn_B_unit(const unsigned char* mb, const unsigned char* ws, int hb, int gk, int qt, int w, int lane, LAS float* sc, LAS unsigned char* ldsb, const float* cs) {
    const int g = lane >> 4, li = lane & 15, qi = li >> 2, hh = li & 3;
    const int ql = 4 * w + qi, tq = 32 * qt + ql, h = gk * 4 + hh;
    const int tmin = 32 * qt + 4 * w, tmax = tmin + 3;
    const size_t tau = (size_t)hb * S + tq;
    const float* gb = (const float*)(mb + MB_GB) + tau * 24 + h * 3;
    const float g0 = gb[0], g1 = gb[1], g2 = gb[2];
    f32x4 res[4];
    const int tid = w * 64 + lane;
    const bf16_t* Qp = (const bf16_t*)(mb + MB_QB) + (size_t)(hb * 8 + h) * E + (size_t)tq * 64;
    bf16x8 qraw[2]; qraw[0] = ld16(Qp + 8 * g); qraw[1] = ld16(Qp + 32 + 8 * g);
    f32x4 cv[4]; { const f32x4* c4 = (const f32x4*)(cs + (tau << 4)); cv[0] = c4[0]; cv[1] = c4[1]; cv[2] = c4[2]; cv[3] = c4[3]; }
    Stg r0; stg_load(r0, (const bf16_t*)(mb + MB_KV + 2 * 4 * MiB) + (size_t)(hb * 2 + gk) * E, (const bf16_t*)(mb + MB_KV + 3 * 4 * MiB) + (size_t)(hb * 2 + gk) * E, 0, tid);
    {
        bf16x8 qf[2]; qf[0] = qraw[0]; qf[1] = qraw[1];
        const bf16_t* kc = (const bf16_t*)(ws + WS_KC) + (size_t)(hb * 2 + gk) * 256 * 64;
        const bf16_t* vct = (const bf16_t*)(ws + WS_KC + 512 * 1024) + (size_t)(hb * 2 + gk) * 64 * 256;
        const int cmaxw = tmax >= 31 ? (tmax - 31) >> 4 : -1;
        const int n16 = (cmaxw >> 4) + 1;
        const int cq = tq >= 31 ? (tq - 31) >> 4 : -1;
        f32x4 sa[16];
#pragma unroll
        for (int kt = 0; kt < 16; ++kt) {
            sa[kt] = (f32x4){0.f, 0.f, 0.f, 0.f};
            if (kt < n16) { const bf16_t* kr = kc + (size_t)(16 * kt + li) * 64; sa[kt] = mfma16(ld16(kr + 8 * g), qf[0], sa[kt]); sa[kt] = mfma16(ld16(kr + 32 + 8 * g), qf[1], sa[kt]); }
        }
        const float C2 = 0.125f * LOG2E;
        float mx = -1e30f;
#pragma unroll
        for (int kt = 0; kt < 16; ++kt)
#pragma unroll
            for (int j = 0; j < 4; ++j) if (kt < n16) { const float v = (16 * kt + 4 * g + j <= cq) ? sa[kt][j] * C2 : -1e30f; sa[kt][j] = v; mx = fmaxf(mx, v); }
        mx = fmaxf(mx, shx(mx, 16, lane)); mx = fmaxf(mx, shx(mx, 32, lane));
        float ps = 0.f;
#pragma unroll
        for (int kt = 0; kt < 16; ++kt)
#pragma unroll
            for (int j = 0; j < 4; ++j) if (kt < n16) { const float p = (sa[kt][j] > -1e29f) ? fexp2(sa[kt][j] - mx) : 0.f; sa[kt][j] = p; ps += p; }
        ps += shx(ps, 16, lane); ps += shx(ps, 32, lane);
        const float inv = ps > 0.f ? 1.f / ps : 0.f;
#pragma unroll
        for (int kt = 0; kt < 16; ++kt) if (kt < n16) sa[kt] = sa[kt] * inv;
        f32x4 o[4];
#pragma unroll
        for (int i = 0; i < 4; ++i) o[i] = (f32x4){0.f, 0.f, 0.f, 0.f};
#pragma unroll
        for (int c = 0; c < 8; ++c)
            if (2 * c < n16) { const bf16x8 pf = pack8(sa[2 * c], sa[2 * c + 1]);
#pragma unroll
                for (int dt = 0; dt < 4; ++dt) o[dt] = mfma16(ld16(vct + (size_t)(16 * dt + li) * 256 + c * 32 + 8 * g), pf, o[dt]);
                }
#pragma unroll
        for (int i = 0; i < 4; ++i) res[i] = o[i] * g0;
#pragma unroll
        for (int kt = 0; kt < 16; ++kt)
            if (kt < n16) {
#pragma unroll
                for (int j = 0; j < 4; ++j) { float v = sa[kt][j]; v += qx1(v); v += qx2(v); sa[kt][j] = v; } }
        float nx[17];
#pragma unroll
        for (int kt = 0; kt < 16; ++kt) nx[kt] = shi(sa[kt][0], (lane + 16) & 63);
        nx[16] = 0.f;
#pragma unroll
        for (int kt = 0; kt < 16; ++kt) { const float scv = sa[kt][0] + 2.f * (sa[kt][1] + sa[kt][2] + sa[kt][3]) + (g < 3 ? nx[kt] : nx[kt + 1]);
            if (hh == 0) sc[ql * 64 + 4 * kt + g] = scv; }
    }
    __syncthreads();
    unsigned long long mk0, mk1, mk2, mk3;
    {
        unsigned long long mks[4];
#pragma unroll
        for (int q2 = 0; q2 < 4; ++q2) {
            const int t = 32 * qt + 4 * w + q2, cur = t >> 6, j = lane;
            float v = sc[(4 * w + q2) * 64 + j];
            const bool forced = (j == 0) || (j == cur) || (j == cur - 1);
            v = forced ? 1e4f : ((j <= cur) ? v : -1.f);
            int rank = 0;
            const int jend = (tmax >> 6) + 1;
#pragma unroll 4
            for (int jj = 0; jj < jend; ++jj) { const float ov = __builtin_bit_cast(float, __builtin_amdgcn_readlane(__builtin_bit_cast(int, v), jj)); rank += ((ov > v) || (ov == v && jj < j)) ? 1 : 0; }
            mks[q2] = __ballot(rank < 16);
        }
        mk0 = mks[0]; mk1 = mks[1]; mk2 = mks[2]; mk3 = mks[3];
    }
    LAS unsigned long long* umw = (LAS unsigned long long*)(ldsb + 8192);
    if (lane == 0) umw[w] = mk0 | mk1 | mk2 | mk3;
    __syncthreads();
    int li_l = lane & 15, g_l = lane >> 4; asm volatile("" : "+v"(li_l), "+v"(g_l));
    const unsigned long long selm = qi == 0 ? mk0 : (qi == 1 ? mk1 : (qi == 2 ? mk2 : mk3));
    const unsigned long long um = mk0 | mk1 | mk2 | mk3;
    bf16x8 qf[2];
    {
        qf[1] = qraw[1];
        u32x4 qw = __builtin_bit_cast(u32x4, qraw[0]); float x[8];
        x[0] = bflo(qw.x); x[1] = bfhi(qw.x); x[2] = bflo(qw.y); x[3] = bfhi(qw.y); x[4] = bflo(qw.z); x[5] = bfhi(qw.z); x[6] = bflo(qw.w); x[7] = bfhi(qw.w);
#pragma unroll
        for (int e = 0; e < 8; ++e) { const float other = shx(x[e], 16, lane); const float co = cv[e >> 2][e & 3], si = cv[2 + (e >> 2)][e & 3];
            x[e] = (g_l == 0) ? (x[e] * co - other * si) : ((g_l == 1) ? (x[e] * co + other * si) : x[e]); }
        qw.x = pk_bf16(x[0], x[1]); qw.y = pk_bf16(x[2], x[3]); qw.z = pk_bf16(x[4], x[5]); qw.w = pk_bf16(x[6], x[7]);
        qf[0] = __builtin_bit_cast(bf16x8, qw);
    }
    LAS bf16_t* tb0 = (LAS bf16_t*)(ldsb + 16384); LAS bf16_t* tb1 = tb0 + 9216;
    unsigned long long bum = 0ull;
#pragma unroll
    for (int i = 0; i < 8; ++i) bum |= umw[i];
    const int kbhi_b = (32 * qt + 31) >> 6;
    {
        const bf16_t* K = (const bf16_t*)(mb + MB_KV + 2 * 4 * MiB) + (size_t)(hb * 2 + gk) * E;
        const bf16_t* Vt = (const bf16_t*)(mb + MB_KV + 3 * 4 * MiB) + (size_t)(hb * 2 + gk) * E;
        AState st; st_init(st);
        unsigned long long rem = bum & ((kbhi_b >= 63) ? ~0ull : ((2ull << kbhi_b) - 1ull));
        int kb = 0, cur = 0; bool have = rem != 0ull;
        if (have) { kb = __builtin_ctzll(rem); rem &= rem - 1ull; stg_store(r0, tb0, tid); }
        __syncthreads();
        while (have) {
            const bool hn = rem != 0ull; int kbn = 0; Stg rn;
            if (hn) { kbn = __builtin_ctzll(rem); rem &= rem - 1ull; stg_load(rn, K, Vt, kbn, tid); }
            if ((um >> kb) & 1ull) {
                KV t; lds_frags(t, cur ? tb1 : tb0, li_l, g_l);
                f32x4 s[4]; qk_compute(s, t, qf);
                if (kb > 0 && 64 * kb + 63 <= tmin) {
                    softmax_pv_nomask(st, s, ((selm >> kb) & 1ull) ? 0.f : -1e30f, t.v, lane);
                } else {
                    unsigned vm = 0;
                    if ((selm >> kb) & 1ull) {
#pragma unroll
                        for (int kt = 0; kt < 4; ++kt)
#pragma unroll
                            for (int j = 0; j < 4; ++j) if (64 * kb + 16 * kt + 4 * g_l + j <= tq) vm |= 1u << (kt * 4 + j);
                    }
                    softmax_pv(st, s, vm, t.v, lane);
                }
            }
            if (hn) stg_store(rn, cur ? tb0 : tb1, tid);
            __syncthreads();
            cur ^= 1; kb = kbn; have = hn;
        }
        const float inv = st_inv_l(st, lane) * g1;
#pragma unroll
        for (int i = 0; i < 4; ++i) res[i] += st.o[i] * inv;
    }
    {
        const bf16_t* K = (const bf16_t*)(mb + MB_KV + 4 * 4 * MiB) + (size_t)(hb * 2 + gk) * E;
        const bf16_t* Vt = (const bf16_t*)(mb + MB_KV + 5 * 4 * MiB) + (size_t)(hb * 2 + gk) * E;
        AState st; st_init(st);
        const int kblo = (32 * qt > 511 ? 32 * qt - 511 : 0) >> 6;
        int cur = 0;
        { Stg r; stg_load(r, K, Vt, kblo, tid); stg_store(r, tb0, tid); }
        __syncthreads();
        for (int kb = kblo; kb <= kbhi_b; ++kb) {
            const bool hn = kb < kbhi_b; Stg rn;
            if (hn) stg_load(rn, K, Vt, kb + 1, tid);
            {
                KV t; lds_frags(t, cur ? tb1 : tb0, li_l, g_l);
                f32x4 s[4]; qk_compute(s, t, qf);
                if (64 * kb >= tmax - 511 && 64 * kb + 63 <= tmin) {
                    softmax_pv_nomask(st, s, 0.f, t.v, lane);
                } else {
                    unsigned vm = 0;
#pragma unroll
                    for (int kt = 0; kt < 4; ++kt)
#pragma unroll
                        for (int j = 0; j < 4; ++j) { const int dist = tq - (64 * kb + 16 * kt + 4 * g_l + j); if (dist >= 0 && dist <= 511) vm |= 1u << (kt * 4 + j); }
                    softmax_pv(st, s, vm, t.v, lane);
                }
            }
            if (hn) stg_store(rn, cur ? tb0 : tb1, tid);
            __syncthreads();
            cur ^= 1;
        }
        const float inv = st_inv_l(st, lane) * g2;
#pragma unroll
        for (int i = 0; i < 4; ++i) res[i] += st.o[i] * inv;
    }
    store_o((bf16_t*)(mb + MB_O) + tau * 1280 + 384 + h * 64, res, g);
}

__device__ __forceinline__ void compress_block(const unsigned char* mb, unsigned char* ws, int kv, int hb, int gk, int rb, int w, int lane, LAS bf16_t* hid) {
    const int g = lane >> 4, li = lane & 15;
    const bf16_t* src = (const bf16_t*)(mb + MB_KV + (size_t)kv * 4 * MiB) + (size_t)(hb * 2 + gk) * E;
    const bf16_t* W1t = (const bf16_t*)(ws + WS_CW1) + (size_t)kv * 128 * 2048 + (size_t)(16 * w + li) * 2048 + 8 * g;
    const bf16_t* W2t = (const bf16_t*)(ws + WS_CW2) + (size_t)kv * 64 * 128;
    const float* bias = (const float*)(ws + WS_CW2 + 65536) + kv * 128;
    const int row = 16 * rb + li;
    f32x4 hacc = {0.f, 0.f, 0.f, 0.f};
#pragma unroll 8
    for (int lt = 0; lt < 32; ++lt) {
        int tok = 16 * row + lt; tok = tok < S ? tok : S - 1;
        const bf16_t* xr = src + (size_t)tok * 64 + 8 * g;
        hacc = mfma16(ld16(W1t + lt * 64), ld16(xr), hacc);
        hacc = mfma16(ld16(W1t + lt * 64 + 32), ld16(xr + 32), hacc);
    }
    float hv[4];
#pragma unroll
    for (int j = 0; j < 4; ++j) { const float x = hacc[j] + bias[16 * w + 4 * g + j];
        const float y = 0.7978845608028654f * (x + 0.044715f * x * x * x);
        const float th = 1.f - 2.f * frcp(fexp2(2.f * y * LOG2E) + 1.f);
        hv[j] = 0.5f * x * (1.f + th); }
    { u32x2 wv; wv.x = pk_bf16(hv[0], hv[1]); wv.y = pk_bf16(hv[2], hv[3]); *(LAS u32x2*)(hid + li * 136 + 16 * w + 4 * g) = wv; }
    __syncthreads();
    if (w < 4) {
        const int dt = w;
        f32x4 o = {0.f, 0.f, 0.f, 0.f};
#pragma unroll
        for (int c = 0; c < 4; ++c) {
            const u32x2 plo = *(const LAS u32x2*)(hid + li * 136 + 32 * c + 4 * g), phi = *(const LAS u32x2*)(hid + li * 136 + 32 * c + 16 + 4 * g);
            u32x4 pv; pv.x = plo.x; pv.y = plo.y; pv.z = phi.x; pv.w = phi.y;
            const bf16_t* wr_ = W2t + (size_t)(16 * dt + li) * 128 + 32 * c + 4 * g;
            const u32x2 lo = *(const u32x2*)wr_, hi = *(const u32x2*)(wr_ + 16);
            u32x4 wv; wv.x = lo.x; wv.y = lo.y; wv.z = hi.x; wv.w = hi.y;
            o = mfma16(__builtin_bit_cast(bf16x8, wv), __builtin_bit_cast(bf16x8, pv), o);
        }
        if (kv == 0) { bf16_t* kc = (bf16_t*)(ws + WS_KC) + (size_t)(hb * 2 + gk) * 256 * 64 + (size_t)row * 64 + 16 * dt + 4 * g;
            u32x2 wv; wv.x = pk_bf16(o[0], o[1]); wv.y = pk_bf16(o[2], o[3]); *(u32x2*)kc = wv; }
        else { bf16_t* vct = (bf16_t*)(ws + WS_KC + 512 * 1024) + (size_t)(hb * 2 + gk) * 64 * 256 + perm32pos(row);
#pragma unroll
            for (int j = 0; j < 4; j += 2) { const unsigned wv = pk_bf16(o[j], o[j + 1]); vct[(size_t)(16 * dt + 4 * g + j) * 256] = (bf16_t)(wv & 0xffffu); vct[(size_t)(16 * dt + 4 * g + j + 1) * 256] = (bf16_t)(wv >> 16); } }
    }
    __syncthreads();
}

__device__ __forceinline__ void transpose_wave(const bf16_t* src, bf16_t* dst, int dl, int pb, bf16_t* tile, int lane) {
    const int L = S >> dl, pstart = 64 * pb, rho = pstart >> (12 - dl), mk0 = pstart & (L - 1);
#pragma unroll
    for (int i = 0; i < 8; ++i) { const int key = 8 * i + (lane >> 3); const int tok = rho + ((mk0 + key) << dl);
        *(bf16x8*)(tile + key * 72 + 8 * (lane & 7)) = ld16(src + (size_t)tok * 64 + 8 * (lane & 7)); }
    asm volatile("s_waitcnt vmcnt(0) lgkmcnt(0)" ::: "memory");
#pragma unroll
    for (int i = 0; i < 8; ++i) { const int o = lane + 64 * i, d = o >> 3, grp = o & 7, kb0 = 32 * (grp >> 2) + 4 * (grp & 3);
        unsigned short v[8];
#pragma unroll
        for (int e = 0; e < 8; ++e) v[e] = tile[(kb0 + (e < 4 ? e : 12 + e)) * 72 + d];
        u32x4 w; w.x = v[0] | ((unsigned)v[1] << 16); w.y = v[2] | ((unsigned)v[3] << 16); w.z = v[4] | ((unsigned)v[5] << 16); w.w = v[6] | ((unsigned)v[7] << 16);
        *(u32x4*)(dst + (size_t)d * S + pstart + 8 * grp) = w; }
    asm volatile("s_waitcnt lgkmcnt(0)" ::: "memory");
}

__device__ __forceinline__ float wave_sum(float v, int lane) {
#pragma unroll
    for (int o = 1; o < 64; o <<= 1) v += shx(v, o, lane);
    return v;
}
__device__ __forceinline__ void norm_rows_bf16(const float* src, const float* gain, bf16_t* dst, int gw, int ngw, int lane) {
    f32x4 gv[4];
#pragma unroll
    for (int j = 0; j < 4; ++j) gv[j] = *(const f32x4*)(gain + 4 * lane + 256 * j);
    for (int row0 = gw; row0 < T; row0 += 4 * ngw) {
        f32x4 v[4][4]; float ss[4];
#pragma unroll
        for (int r = 0; r < 4; ++r) { const int row = row0 + r * ngw; const float* xr = src + (size_t)(row < T ? row : row0) * D + 4 * lane; ss[r] = 0.f;
#pragma unroll
            for (int j = 0; j < 4; ++j) { v[r][j] = *(const f32x4*)(xr + 256 * j); ss[r] += (v[r][j][0] * v[r][j][0] + v[r][j][1] * v[r][j][1]) + (v[r][j][2] * v[r][j][2] + v[r][j][3] * v[r][j][3]); } }
#pragma unroll
        for (int o = 1; o < 64; o <<= 1) {
#pragma unroll
            for (int r = 0; r < 4; ++r) ss[r] += shx(ss[r], o, lane); }
#pragma unroll
        for (int r = 0; r < 4; ++r) { const int row = row0 + r * ngw; if (row < T) { const float rstd = 1.f / sqrtf(ss[r] * (1.f / D) + 1e-6f);
            bf16_t* orow = dst + (size_t)row * D + 4 * lane;
#pragma unroll
            for (int j = 0; j < 4; ++j) { const f32x4 y = v[r][j] * rstd * gv[j]; u32x2 w; w.x = pk_bf16(y[0], y[1]); w.y = pk_bf16(y[2], y[3]); *(u32x2*)(orow + 256 * j) = w; } } }
    }
}
__device__ __forceinline__ void norm_rows_f32_inplace(float* buf, const float* gain, int gw, int ngw, int lane) {
    f32x4 gv[4];
#pragma unroll
    for (int j = 0; j < 4; ++j) gv[j] = *(const f32x4*)(gain + 4 * lane + 256 * j);
    for (int row = gw; row < T; row += ngw) {
        float* xr = buf + (size_t)row * D + 4 * lane; f32x4 v[4]; float ss = 0.f;
#pragma unroll
        for (int j = 0; j < 4; ++j) { v[j] = *(const f32x4*)(xr + 256 * j); ss += (v[j][0] * v[j][0] + v[j][1] * v[j][1]) + (v[j][2] * v[j][2] + v[j][3] * v[j][3]); }
        const float rstd = 1.f / sqrtf(wave_sum(ss, lane) * (1.f / D) + 1e-6f);
#pragma unroll
        for (int j = 0; j < 4; ++j) *(f32x4*)(xr + 256 * j) = v[j] * rstd * gv[j];
    }
}
__device__ __forceinline__ void tr_item(const float* base, int nvalid, int ld, int k0, bf16_t* WT, int K, int n0, float* scr, int lane) {
    const int g4 = lane & 7;
#pragma unroll
    for (int i = 0; i < 8; ++i) { const int kk = 8 * i + (lane >> 3);
        f32x4 v = {0.f, 0.f, 0.f, 0.f};
        if (4 * g4 < nvalid) v = *(const f32x4*)(base + (size_t)(k0 + kk) * ld + 4 * g4);
        float* d = scr + kk * 33 + 4 * g4; d[0] = v[0]; d[1] = v[1]; d[2] = v[2]; d[3] = v[3]; }
    asm volatile("s_waitcnt lgkmcnt(0)" ::: "memory");
    const int c = lane & 7;
#pragma unroll
    for (int j = 0; j < 4; ++j) { const int n = (lane >> 3) + 8 * j; const float* s = scr + (8 * c) * 33 + n;
        u32x4 o; o.x = pk_bf16(s[0 * 33], s[1 * 33]); o.y = pk_bf16(s[2 * 33], s[3 * 33]); o.z = pk_bf16(s[4 * 33], s[5 * 33]); o.w = pk_bf16(s[6 * 33], s[7 * 33]);
        *(u32x4*)(WT + (size_t)(n0 + n) * K + k0 + 8 * c) = o; }
    asm volatile("s_waitcnt lgkmcnt(0)" ::: "memory");
}
__device__ __forceinline__ void conv_ffn(const float* w1, const float* w3, const float* w2, unsigned char* ws, float* scr, int gw, int ngw, int lane) {
    constexpr int I13 = 16 * 176, I2 = 44 * 32;
    bf16_t* W13t = (bf16_t*)(ws + WS_W13); bf16_t* W2t = (bf16_t*)(ws + WS_W2);
    for (int it = gw; it < I13 + I2; it += ngw) {
        if (it < I13) { const int kb = it / 176, nb = it % 176, n = 32 * nb, j = 128 * (n >> 8) + (n & 127);
            tr_item(((n & 255) < 128 ? w1 : w3) + j, 32, FF, 64 * kb, W13t, D, 32 * nb, scr, lane); }
        else { const int r = it - I13, kb = r / 32, nb = r % 32; tr_item(w2 + 32 * nb, 32, D, 64 * kb, W2t, FF, 32 * nb, scr, lane); }
    }
}
__device__ __forceinline__ void conv_mixer(const float* w_in, const float* w_gate, const float* w_up, const float* w_out, const float* cw1k, const float* cw2k, const float* cw1v, const float* cw2v,
                                           const float* pek, const float* pev, unsigned char* ws, float* scr, int gw, int ngw, int lane) {
    constexpr int I_IN = 16 * 288, I_UP0 = 6 * 32, I_UP1 = 8 * 32, I_UP2 = 6 * 32, I_OUT = 16 * 32, I_C1 = 32 * 4, I_C2 = 2 * 2, I_B = 8;
    constexpr int NI = I_IN + I_UP0 + I_UP1 + I_UP2 + I_OUT + 2 * I_C1 + 2 * I_C2 + I_B;
    for (int it = gw; it < NI; it += ngw) {
        int r = it;
        if (r < I_IN) { const int kb = r / 288, nb = r % 288, n = 32 * nb; const float* base = w_in; int nvalid = 0;
            if (n >= NPROJ) { base = w_gate + (n - NPROJ); nvalid = 32; }
            else if ((n >> 6) == 74) { if ((n & 63) == 0) { base = w_in + 4736; nvalid = 24; } }
            else { const int oc = in_orig_col(n); if (oc >= 0) { base = w_in + oc; nvalid = 32; } }
            tr_item(base, nvalid, n >= NPROJ ? 3072 : 5912, 64 * kb, (bf16_t*)(ws + WS_WIN), D, 32 * nb, scr, lane); continue; }
        r -= I_IN;
        if (r < I_UP0) { const int kb = r / 32, nb = r % 32; tr_item(w_up + 32 * nb, 32, D, 64 * kb, (bf16_t*)(ws + WS_WUP), 384, 32 * nb, scr, lane); continue; }
        r -= I_UP0;
        if (r < I_UP1) { const int kb = r / 32, nb = r % 32; tr_item(w_up + (size_t)384 * D + 32 * nb, 32, D, 64 * kb, (bf16_t*)(ws + WS_WUP) + 1024 * 384, 512, 32 * nb, scr, lane); continue; }
        r -= I_UP1;
        if (r < I_UP2) { const int kb = r / 32, nb = r % 32; tr_item(w_up + (size_t)896 * D + 32 * nb, 32, D, 64 * kb, (bf16_t*)(ws + WS_WUP) + 1024 * 896, 384, 32 * nb, scr, lane); continue; }
        r -= I_UP2;
        if (r < I_OUT) { const int kb = r / 32, nb = r % 32; tr_item(w_out + 32 * nb, 32, D, 64 * kb, (bf16_t*)(ws + WS_WOUT), D, 32 * nb, scr, lane); continue; }
        r -= I_OUT;
        if (r < 2 * I_C1) { const int kv = r / I_C1, q = r % I_C1, kb = q / 4, nb = q % 4; tr_item((kv ? cw1v : cw1k) + 32 * nb, 32, 128, 64 * kb, (bf16_t*)(ws + WS_CW1) + (size_t)kv * 128 * 2048, 2048, 32 * nb, scr, lane); continue; }
        r -= 2 * I_C1;
        if (r < 2 * I_C2) { const int kv = r / I_C2, q = r % I_C2, kb = q / 2, nb = q % 2; tr_item((kv ? cw2v : cw2k) + 32 * nb, 32, 64, 64 * kb, (bf16_t*)(ws + WS_CW2) + (size_t)kv * 64 * 128, 128, 32 * nb, scr, lane); continue; }
        r -= 2 * I_C2;
        {
            const int kv = r >> 2, n = 32 * (r & 3) + (lane & 31); const float* pe = kv ? pev : pek; const float* w1 = kv ? cw1v : cw1k; float a = 0.f;
            for (int kq = (lane >> 5); kq < 2048; kq += 2) a += pe[kq] * w1[(size_t)kq * 128 + n];
            a += shx(a, 32, lane);
            if (lane < 32) ((float*)(ws + WS_CW2 + 65536))[kv * 128 + n] = a;
        }
    }
}

#ifndef DUP
#define DUP 0
#endif
#ifndef NHF
#define NHF 2
#endif
#ifndef PHM
#define PHM 0xFFFF
#endif
struct Params { const float* in[22]; float* out; unsigned char* ws; };

#define BW_XC(j) (2048 + 64 * (j))
#define BW_XS(j) (2560 + 64 * (j))
#define BW_XG(j) (3072 + 64 * (j))
#define BW_TOP 3584
#define BW_TG 3648
__device__ __forceinline__ unsigned bw_ld(unsigned* p) { return __hip_atomic_load(p, __ATOMIC_RELAXED, __HIP_MEMORY_SCOPE_AGENT); }
__device__ __forceinline__ unsigned bw_add(unsigned* p) { return __hip_atomic_fetch_add(p, 1u, __ATOMIC_RELAXED, __HIP_MEMORY_SCOPE_AGENT); }
__device__ __forceinline__ void grid_bar2(unsigned* ctl, unsigned n, bool leader) {
    asm volatile("s_waitcnt vmcnt(0) lgkmcnt(0)" ::: "memory");
    __syncthreads();
    if (leader) {
        const unsigned x = (unsigned)__builtin_amdgcn_s_getreg((3 << 11) | 20) & 7u;
        const unsigned nloc = bw_ld(ctl + BW_XC(x));
        unsigned nx = 0;
#pragma unroll
        for (int j = 0; j < 8; ++j) nx += bw_ld(ctl + BW_XC(j)) != 0u ? 1u : 0u;
        const unsigned old = bw_add(ctl + BW_XS(x));
        if (old + 1u == n * nloc) {
            __builtin_amdgcn_fence(__ATOMIC_RELEASE, "agent");
            asm volatile("s_waitcnt vmcnt(0)" ::: "memory");
            const unsigned og = bw_add(ctl + BW_TOP);
            if (og + 1u == n * nx) bw_add(ctl + BW_TG);
            else while (bw_ld(ctl + BW_TG) < n) __builtin_amdgcn_s_sleep(2);
            bw_add(ctl + BW_XG(x));
        } else {
            while (bw_ld(ctl + BW_XG(x)) < n) __builtin_amdgcn_s_sleep(2);
        }
        __builtin_amdgcn_fence(__ATOMIC_ACQUIRE, "agent");
        asm volatile("s_waitcnt vmcnt(0)" ::: "memory");
    }
    __syncthreads();
}
__global__ void __launch_bounds__(NTHREADS, 2) hybrid_fwd(Params p) {
    extern __shared__ __attribute__((aligned(16))) unsigned char lds_raw[];
    cg::grid_group grid = cg::this_grid();
    LAS unsigned char* lds = (LAS unsigned char*)lds_raw;
    const int G0 = gridDim.x;
    unsigned nbar = 0;
#define GBAR() do { ++nbar; int l_; asm volatile("v_mbcnt_lo_u32_b32 %0, -1, 0\n\tv_mbcnt_hi_u32_b32 %0, -1, %0" : "=v"(l_)); unsigned char* w_ = p.ws; asm volatile("" : "+s"(w_)); grid_bar2((unsigned*)(w_ + WS_CTL), nbar, wave0 == 0 && l_ == 0); } while (0)
#define GSYNC() GBAR()
    const int wave0 = __builtin_amdgcn_readfirstlane(threadIdx.x >> 6);
#define PH int G = G0; asm volatile("" : "+s"(G)); const int ngw = G * NWAVES; (void)ngw; int lane_; asm volatile("v_mbcnt_lo_u32_b32 %0, -1, 0\n\tv_mbcnt_hi_u32_b32 %0, -1, %0" : "=v"(lane_)); int bid_ = blockIdx.x; int wave_ = wave0; asm volatile("" : "+s"(bid_), "+s"(wave_)); const int lane = lane_, wave = wave_, tid = wave * 64 + lane, gw = bid_ * NWAVES + wave; (void)tid; \
    unsigned char* ws = p.ws; float* out = p.out; asm volatile("" : "+s"(ws), "+s"(out)); \
    float* scr = (float*)(lds_raw + wave * 16384); unsigned char* mb = ws + WS_R; bf16_t* U = (bf16_t*)(ws + WS_U); bf16_t* ACT = (bf16_t*)(ws + WS_R); \
    (void)lane; (void)gw; (void)scr; (void)mb; (void)U; (void)ACT;

    if (threadIdx.x == 0) { const unsigned x = (unsigned)__builtin_amdgcn_s_getreg((3 << 11) | 20) & 7u; bw_add((unsigned*)(p.ws + WS_CTL) + BW_XC(x)); }
    {
        PH
        float* cs = (float*)(ws + WS_CS);
        const int* pos = (const int*)p.in[1];
        for (int i = bid_ * NTHREADS + tid; i < T * 8; i += G * NTHREADS) {
            const int tok = i >> 3, f = i & 7;
            const float ang = (float)pos[tok] * ROPE_INV[f];
            double rev = (double)ang * 0.15915494309189535; rev -= floor(rev);
            const float rf = (float)rev;
            cs[(size_t)tok * 16 + f] = __builtin_amdgcn_cosf(rf); cs[(size_t)tok * 16 + 8 + f] = __builtin_amdgcn_sinf(rf);
        }
    }

    for (int layer = 0; layer < DEPTH; ++layer) {
        { PH
          if (PHM & 1) conv_ffn(p.in[3] + (size_t)layer * D * FF, p.in[4] + (size_t)layer * D * FF, p.in[5] + (size_t)layer * FF * D, ws, scr, gw, ngw, lane);
          if (PHM & 1) norm_rows_bf16(layer == 0 ? p.in[0] : out, p.in[2] + layer * D, U, gw, ngw, lane); }
        if (layer == 0) grid.sync(); else GBAR();
        { PH
          for (int rep = 0; rep < ((DUP & 1) ? 2 : 1); ++rep) { EpiFfnUp Ep{ACT}; run_gemm(lds, U, D, (const bf16_t*)(ws + WS_W13), T, 2 * FF, D, Ep, wave); } }
        GSYNC();
        { PH
          if (PHM & 4) { EpiResid Ep{layer == 0 ? p.in[0] : out, out, 0.5f}; run_gemm(lds, ACT, FF, (const bf16_t*)(ws + WS_W2), T, D, FF, Ep, wave); } }
        GSYNC();
        { PH
          if (PHM & 8) conv_mixer(p.in[7] + (size_t)layer * D * 5912, p.in[14] + (size_t)layer * D * 3072, p.in[15] + (size_t)layer * 1280 * D, p.in[16] + (size_t)layer * D * D,
                   p.in[9] + (size_t)layer * 2048 * 128, p.in[10] + (size_t)layer * 128 * 64, p.in[12] + (size_t)layer * 2048 * 128, p.in[13] + (size_t)layer * 128 * 64,
                   p.in[8] + (size_t)layer * 2048, p.in[11] + (size_t)layer * 2048, ws, scr, gw, ngw, lane);
          norm_rows_bf16(out, p.in[6] + layer * D, U, gw, ngw, lane); }
        GSYNC();
        for (int hf = 0; hf < NHF; ++hf) {
            { PH
              for (int rep = 0; rep < ((DUP & 2) ? 2 : 1); ++rep) { EpiInProj Ep{mb, (const float*)(ws + WS_CS) + (size_t)hf * TH * 16}; run_gemm(lds, U + (size_t)hf * TH * D, D, (const bf16_t*)(ws + WS_WIN), TH, NIN, D, Ep, wave); } }
            GSYNC();
            { PH
              if ((PHM & 0x1C0) != 0x1C0) { u32x4* Oz = (u32x4*)(mb + MB_O); for (size_t i = (size_t)bid_ * NTHREADS + tid; i < (size_t)TH * 1280 / 8; i += (size_t)G * NTHREADS) Oz[i] = (u32x4){0u, 0u, 0u, 0u}; }
              for (int it = gw; it < 7168; it += ngw) {
                  const unsigned char* sb; unsigned char* db; int dl = 0, hi, pb = it & 63; const int q = it >> 6;
                  if (q < 72) { const int g3 = q / 24; hi = q % 24; sb = mb + MB_VRM + (size_t)g3 * 12 * MiB; db = mb + MB_VA + (size_t)g3 * 12 * MiB; dl = 2 * g3; }
                  else if (q < 80) { hi = q - 72; sb = mb + MB_VRM + 36 * MiB; db = mb + MB_KV + 3 * 4 * MiB; }
                  else if (q < 88) { hi = q - 80; sb = mb + MB_VRM + 40 * MiB; db = mb + MB_KV + 5 * 4 * MiB; }
                  else { hi = q - 88; sb = mb + MB_VRM + 44 * MiB; db = mb + MB_VC; }
                  transpose_wave((const bf16_t*)sb + (size_t)hi * E, (bf16_t*)db + (size_t)hi * E, dl, pb, (bf16_t*)scr, lane);
              }
              for (int it = bid_; it < 256; it += G) { const int kv = it >> 7, hb = (it >> 5) & 3, gk = (it >> 4) & 1, rb = it & 15; compress_block(mb, ws, kv, hb, gk, rb, wave, lane, (LAS bf16_t*)(lds + 125952)); } }
            GSYNC();
            {
                PH
                LAS unsigned* sidx = (LAS unsigned*)(lds + LDS_MISC);
                const int xcd = bid_ & 7;
                unsigned* ctr = (unsigned*)(ws + WS_CTL) + ((layer * 2 + hf) * 8 + xcd) * 64;
                LAS float* sc = (LAS float*)lds;
                unsigned nxt = 0u; if (tid == 0) nxt = atomicAdd(ctr, 1u);
                for (;;) {
                    __syncthreads();
                    if (tid == 0) *sidx = nxt;
                    __syncthreads();
                    const int idx = (int)*sidx;
                    if (idx >= 320) break;
                    if (tid == 0) nxt = atomicAdd(ctr, 1u);
                    int ln = lane; asm volatile("" : "+v"(ln));
                    if (idx < 128) { const int qt = 127 - idx; attn_B_unit(mb, ws, xcd >> 1, xcd & 1, qt, wave, ln, sc, lds, (const float*)(ws + WS_CS) + (size_t)hf * TH * 16); }
                    else if (idx < 224) { const int i = idx - 128, pr = xcd * 3 + i / 32, j = i % 32; attn_A_wave(mb, pr / 6, pr % 6, j >> 1, (j & 1) * 8 + wave, ln, wave, lds); }
                    else { const int i = idx - 224, pr = xcd * 3 + i / 32, qb = 31 - (i % 32); attn_C_wave(mb, pr / 6, pr % 6, qb, wave, ln); }
                }
            }
            GSYNC();
            { PH
              if (PHM & 512) { EpiUpMerge<true> Ep{(const bf16_t*)(mb + MB_G), (bf16_t*)(mb + MB_Y)}; run_gemm(lds, (const bf16_t*)(mb + MB_O), 1280, (const bf16_t*)(ws + WS_WUP), TH, D, 384, Ep, wave); } }
            { PH
              if (PHM & 512) { EpiUpMerge<false> Ep{(const bf16_t*)(mb + MB_G) + 1024, (bf16_t*)(mb + MB_Y)}; run_gemm(lds, (const bf16_t*)(mb + MB_O) + 384, 1280, (const bf16_t*)(ws + WS_WUP) + 1024 * 384, TH, D, 512, Ep, wave); } }
            { PH
              if (PHM & 512) { EpiUpMerge<false> Ep{(const bf16_t*)(mb + MB_G) + 2048, (bf16_t*)(mb + MB_Y)}; run_gemm(lds, (const bf16_t*)(mb + MB_O) + 896, 1280, (const bf16_t*)(ws + WS_WUP) + 1024 * 896, TH, D, 384, Ep, wave); } }
            GSYNC();
            { PH
              if (PHM & 4) { float* hh = out + (size_t)hf * TH * D; EpiResid Ep{hh, hh, 1.0f}; run_gemm(lds, (const bf16_t*)(mb + MB_Y), D, (const bf16_t*)(ws + WS_WOUT), TH, D, D, Ep, wave); } }
            GSYNC();
        }
        { PH
          if (PHM & 1) conv_ffn(p.in[18] + (size_t)layer * D * FF, p.in[19] + (size_t)layer * D * FF, p.in[20] + (size_t)layer * FF * D, ws, scr, gw, ngw, lane);
          norm_rows_bf16(out, p.in[17] + layer * D, U, gw, ngw, lane); }
        GSYNC();
        { PH
          if (PHM & 2) { EpiFfnUp Ep{ACT}; run_gemm(lds, U, D, (const bf16_t*)(ws + WS_W13), T, 2 * FF, D, Ep, wave); } }
        GSYNC();
        { PH
          if (PHM & 4) { EpiResid Ep{out, out, 0.5f}; run_gemm(lds, ACT, FF, (const bf16_t*)(ws + WS_W2), T, D, FF, Ep, wave); } }
        GSYNC();
    }
    { PH
      norm_rows_f32_inplace(out, p.in[21], gw, ngw, lane); }
}

extern "C" void kernel_launch(void* const* d_in, const int* in_sizes, int n_in, void* d_out, int out_size, void* d_ws, size_t ws_size, hipStream_t stream) {
    static int grid_blocks = 0;
    if (grid_blocks == 0) {
        if (n_in != 22 || out_size != T * D || ws_size < WS_NEED) { fprintf(stderr, "kernel_launch: unexpected shapes (n_in %d out %d ws %zu, need %zu)\n", n_in, out_size, ws_size, (size_t)WS_NEED); grid_blocks = -1; return; }
        int dev = 0, cus = 0, per_cu = 0;
        hipGetDevice(&dev);
        hipDeviceGetAttribute(&cus, hipDeviceAttributeMultiprocessorCount, dev);
        if (hipFuncSetAttribute((const void*)hybrid_fwd, hipFuncAttributeMaxDynamicSharedMemorySize, LDS_BYTES) != hipSuccess) { fprintf(stderr, "kernel_launch: hipFuncSetAttribute failed\n"); grid_blocks = -1; return; }
        hipOccupancyMaxActiveBlocksPerMultiprocessor(&per_cu, (const void*)hybrid_fwd, NTHREADS, LDS_BYTES);
        if (per_cu < 1) { fprintf(stderr, "kernel_launch: occupancy query says %d blocks/CU\n", per_cu); per_cu = 1; }
        (void)hipGetLastError();
        grid_blocks = cus & ~7;
        if (grid_blocks < 8) { fprintf(stderr, "kernel_launch: needs at least 8 CUs\n"); grid_blocks = -1; return; }
    }
    if (grid_blocks < 0) return;
    hipMemsetAsync((char*)d_ws + WS_CTL, 0, 16384, stream);
    Params p{};
    for (int i = 0; i < 22; ++i) p.in[i] = (const float*)d_in[i];
    p.out = (float*)d_out; p.ws = (unsigned char*)d_ws;
    void* args[] = {&p};
    hipError_t e = hipLaunchCooperativeKernel((const void*)hybrid_fwd, dim3(grid_blocks), dim3(NTHREADS), args, LDS_BYTES, stream);
    if (e != hipSuccess) fprintf(stderr, "cooperative launch failed: %s (grid %d)\n", hipGetErrorString(e), grid_blocks);
}
```
